# Optimizing an MI355X kernel written in HIP

```python
import jax, jax.numpy as jnp
from jax import lax
import numpy as np

D_MODEL = 1024
BATCH = 8
SEQ = 4096
DEPTH = 2

N_HEADS = 16
HEAD_DIM = 64
ATTN_DIM = N_HEADS * HEAD_DIM
ROT_DIM = HEAD_DIM // 4
ROPE_THETA = 500000.0
D_FF = 2816
FFN_RESIDUAL_WEIGHT = 0.5
N_A_LAYERS = DEPTH // 2
N_B_LAYERS = DEPTH - N_A_LAYERS
DILATION_PAIRS = ((128, 1), (512, 4), (2048, 16))
MOBA_BLOCK = 256
MOBA_TOPK = 3
MOBA_Q_CHUNK = 32
RMS_EPS = 1e-6

kernel_name = 'hybrid_dilated_moba_yoco'


def rmsnorm(x, g):
    xf = x.astype(jnp.float32)
    y = xf * lax.rsqrt(jnp.mean(xf * xf, axis=-1, keepdims=True) + RMS_EPS)
    return (y * g.astype(jnp.float32)).astype(x.dtype)


def swiglu(h, w_gate, w_up, w_down):
    return (jax.nn.silu(h @ w_gate) * (h @ w_up)) @ w_down


def partial_rotary(t, pos):
    half = ROT_DIM // 2
    inv_freq = ROPE_THETA ** (-jnp.arange(half, dtype=jnp.float32) / half)
    ang = pos.astype(jnp.float32)[:, None] * inv_freq[None, :]
    cos, sin = jnp.cos(ang), jnp.sin(ang)
    tf = t.astype(jnp.float32)
    x1, x2 = tf[..., :half], tf[..., half:ROT_DIM]
    out = jnp.concatenate([x1 * cos - x2 * sin, x1 * sin + x2 * cos, tf[..., ROT_DIM:]], axis=-1)
    return out.astype(t.dtype)


def dilated_branch(q, k, v, window, dil):
    B, H, S, Dh = q.shape
    blk = window // dil
    span = blk * dil
    s_pad = -(-S // span) * span
    L = s_pad // dil
    nb = L // blk

    def to_sub(t):
        t = jnp.pad(t, ((0, 0), (0, 0), (0, s_pad - S), (0, 0)))
        t = t.reshape(B, H, L, dil, Dh).transpose(0, 1, 3, 2, 4)
        return t.reshape(B, H, dil, nb, blk, Dh)

    qs, ks, vs = to_sub(q), to_sub(k), to_sub(v)

    def with_prev(t):
        prev = jnp.pad(t, ((0, 0), (0, 0), (0, 0), (1, 0), (0, 0), (0, 0)))[:, :, :, :-1]
        return jnp.concatenate([prev, t], axis=4)

    kk, vv = with_prev(ks), with_prev(vs)
    s = jnp.einsum('bhrnqd,bhrnkd->bhrnqk', qs, kk).astype(jnp.float32) * (HEAD_DIM ** -0.5)
    qi = jnp.arange(blk)[:, None]
    kj = jnp.arange(2 * blk)[None, :]
    diff = blk + qi - kj
    band = (diff >= 0) & (diff <= blk)
    has_prev = (jnp.arange(nb)[:, None, None] > 0) | (kj[None] >= blk)
    mask = band[None] & has_prev
    s = jnp.where(mask, s, -jnp.inf)
    m = jnp.max(s, axis=-1, keepdims=True)
    p = jnp.exp(s - m)
    l = jnp.sum(p, axis=-1, keepdims=True)
    o = jnp.einsum('bhrnqk,bhrnkd->bhrnqd', (p / l).astype(v.dtype), vv)
    lse = m + jnp.log(l)

    def from_sub(t):
        X = t.shape[-1]
        t = t.reshape(B, H, dil, L, X).transpose(0, 1, 3, 2, 4).reshape(B, H, s_pad, X)
        return t[:, :, :S]

    return from_sub(o), from_sub(lse)[..., 0]


def mixer_a(h, w_qkv, w_o, pos):
    B, S, _ = h.shape
    qkv = (h @ w_qkv).reshape(B, S, 3, N_HEADS, HEAD_DIM).transpose(2, 0, 3, 1, 4)
    q, k, v = partial_rotary(qkv[0], pos), partial_rotary(qkv[1], pos), qkv[2]
    outs, lses = [], []
    for window, dil in DILATION_PAIRS:
        o_i, lse_i = dilated_branch(q, k, v, window, dil)
        outs.append(o_i)
        lses.append(lse_i)
    wts = jax.nn.softmax(jnp.stack(lses, axis=0), axis=0)
    o = jnp.sum(wts[..., None] * jnp.stack(outs, axis=0).astype(jnp.float32), axis=0).astype(h.dtype)
    return o.transpose(0, 2, 1, 3).reshape(B, S, ATTN_DIM) @ w_o


def shared_kv(h_stream, kv_norm, kv_w, pos):
    B, S, _ = h_stream.shape
    hn = rmsnorm(h_stream, kv_norm)
    kv = (hn @ kv_w).reshape(B, S, 2, N_HEADS, HEAD_DIM).transpose(2, 0, 3, 1, 4)
    k, v = partial_rotary(kv[0], pos), kv[1]
    s_pad = -(-S // MOBA_BLOCK) * MOBA_BLOCK
    pad = ((0, 0), (0, 0), (0, s_pad - S), (0, 0))
    k_pad, v_pad = jnp.pad(k, pad), jnp.pad(v, pad)
    nb = s_pad // MOBA_BLOCK
    k_mean = jnp.mean(k_pad.reshape(B, N_HEADS, nb, MOBA_BLOCK, HEAD_DIM).astype(jnp.float32), axis=3)
    return k_pad, v_pad, k_mean.astype(k.dtype)


def mixer_b(h, w_q, w_o, k_pad, v_pad, k_mean, pos):
    B, S, _ = h.shape
    q = (h @ w_q).reshape(B, S, N_HEADS, HEAD_DIM).transpose(0, 2, 1, 3)
    q = partial_rotary(q, pos)
    nb = k_mean.shape[2]
    ksel = min(MOBA_TOPK, nb)
    k_blocks = k_pad.reshape(B, N_HEADS, nb, MOBA_BLOCK, HEAD_DIM)
    v_blocks = v_pad.reshape(B, N_HEADS, nb, MOBA_BLOCK, HEAD_DIM)
    n_chunks = S // MOBA_Q_CHUNK
    q_chunks = q.reshape(B, N_HEADS, n_chunks, MOBA_Q_CHUNK, HEAD_DIM).transpose(2, 0, 1, 3, 4)
    gather = jax.vmap(jax.vmap(lambda blocks, idx: blocks[idx]))
    scale = HEAD_DIM ** -0.5

    def chunk_attend(args):
        c, qc = args
        t = c * MOBA_Q_CHUNK + jnp.arange(MOBA_Q_CHUNK)
        own = (c * MOBA_Q_CHUNK) // MOBA_BLOCK
        gate = jnp.einsum('bhqd,bhnd->bhqn', qc, k_mean).astype(jnp.float32)
        gate = jnp.where(jnp.arange(nb) < own, gate, -jnp.inf)
        _, sel = lax.top_k(gate, ksel)
        valid = sel < own
        k_s = gather(k_blocks, sel)
        v_s = gather(v_blocks, sel)
        s_sel = jnp.einsum('bhqd,bhqnkd->bhqnk', qc, k_s).astype(jnp.float32) * scale
        s_sel = jnp.where(valid[..., None], s_sel, -jnp.inf).reshape(B, N_HEADS, MOBA_Q_CHUNK, ksel * MOBA_BLOCK)
        k_o = lax.dynamic_slice_in_dim(k_pad, own * MOBA_BLOCK, MOBA_BLOCK, axis=2)
        v_o = lax.dynamic_slice_in_dim(v_pad, own * MOBA_BLOCK, MOBA_BLOCK, axis=2)
        s_own = jnp.einsum('bhqd,bhkd->bhqk', qc, k_o).astype(jnp.float32) * scale
        causal = (own * MOBA_BLOCK + jnp.arange(MOBA_BLOCK))[None, :] <= t[:, None]
        s_own = jnp.where(causal, s_own, -jnp.inf)
        p = jax.nn.softmax(jnp.concatenate([s_sel, s_own], axis=-1), axis=-1).astype(qc.dtype)
        p_sel = p[..., :ksel * MOBA_BLOCK].reshape(B, N_HEADS, MOBA_Q_CHUNK, ksel, MOBA_BLOCK)
        p_own = p[..., ksel * MOBA_BLOCK:]
        return (jnp.einsum('bhqnk,bhqnkd->bhqd', p_sel, v_s)
                + jnp.einsum('bhqk,bhkd->bhqd', p_own, v_o))

    out = lax.map(chunk_attend, (jnp.arange(n_chunks), q_chunks))
    out = out.transpose(1, 0, 3, 2, 4).reshape(B, S, ATTN_DIM)
    return out @ w_o


def setup_inputs(seed: int = 0) -> dict:
    key = jax.random.key(seed)
    ks = jax.random.split(key, 18)
    f32 = jnp.float32

    def w(k, shape, fan_in):
        return jax.random.normal(k, shape, f32) * (fan_in ** -0.5)

    def gain(k, shape):
        return 1.0 + 0.02 * jax.random.normal(k, shape, f32)

    return {
        'x': jax.random.normal(ks[0], (BATCH, SEQ, D_MODEL), f32),
        'ffn1_norm': gain(ks[1], (DEPTH, D_MODEL)),
        'ffn1_w_gate': w(ks[2], (DEPTH, D_MODEL, D_FF), D_MODEL),
        'ffn1_w_up': w(ks[3], (DEPTH, D_MODEL, D_FF), D_MODEL),
        'ffn1_w_down': w(ks[4], (DEPTH, D_FF, D_MODEL), D_FF),
        'mix_norm': gain(ks[5], (DEPTH, D_MODEL)),
        'ffn2_norm': gain(ks[6], (DEPTH, D_MODEL)),
        'ffn2_w_gate': w(ks[7], (DEPTH, D_MODEL, D_FF), D_MODEL),
        'ffn2_w_up': w(ks[8], (DEPTH, D_MODEL, D_FF), D_MODEL),
        'ffn2_w_down': w(ks[9], (DEPTH, D_FF, D_MODEL), D_FF),
        'a_w_qkv': w(ks[10], (N_A_LAYERS, D_MODEL, 3 * ATTN_DIM), D_MODEL),
        'a_w_o': w(ks[11], (N_A_LAYERS, ATTN_DIM, D_MODEL), ATTN_DIM),
        'kv_norm': gain(ks[12], (D_MODEL,)),
        'kv_w': w(ks[13], (D_MODEL, 2 * ATTN_DIM), D_MODEL),
        'b_w_q': w(ks[14], (N_B_LAYERS, D_MODEL, ATTN_DIM), D_MODEL),
        'b_w_o': w(ks[15], (N_B_LAYERS, ATTN_DIM, D_MODEL), ATTN_DIM),
        'final_norm': gain(ks[16], (D_MODEL,)),
    }


def reference(x, ffn1_norm, ffn1_w_gate, ffn1_w_up, ffn1_w_down, mix_norm,
              ffn2_norm, ffn2_w_gate, ffn2_w_up, ffn2_w_down, a_w_qkv, a_w_o,
              kv_norm, kv_w, b_w_q, b_w_o, final_norm):
    pos = jnp.arange(x.shape[1], dtype=jnp.int32)
    h = x
    shared = None
    for layer in range(DEPTH):
        h = h + FFN_RESIDUAL_WEIGHT * swiglu(rmsnorm(h, ffn1_norm[layer]),
                                             ffn1_w_gate[layer], ffn1_w_up[layer], ffn1_w_down[layer])
        hn = rmsnorm(h, mix_norm[layer])
        if layer < N_A_LAYERS:
            h = h + mixer_a(hn, a_w_qkv[layer], a_w_o[layer], pos)
        else:
            j = layer - N_A_LAYERS
            h = h + mixer_b(hn, b_w_q[j], b_w_o[j], shared[0], shared[1], shared[2], pos)
        h = h + FFN_RESIDUAL_WEIGHT * swiglu(rmsnorm(h, ffn2_norm[layer]),
                                             ffn2_w_gate[layer], ffn2_w_up[layer], ffn2_w_down[layer])
        if layer == N_A_LAYERS - 1:
            shared = shared_kv(h, kv_norm, kv_w, pos)
    return rmsnorm(h, final_norm)
```

```cpp
#include <hip/hip_runtime.h>
#include <hip/hip_cooperative_groups.h>
#include <cstdio>
#include <cstdint>
#include <cmath>
namespace cg = cooperative_groups;
namespace pg8 {
#define PG8_LAS __attribute__((address_space(3)))
typedef unsigned short bf16_t;
typedef short bf16x8 __attribute__((ext_vector_type(8)));
typedef float f32x4 __attribute__((ext_vector_type(4)));
typedef unsigned u32x4 __attribute__((ext_vector_type(4)));
constexpr int BM = 256, BK = 64, HALF = 128, HTB = HALF * BK * 2  , STAGE_BYTES = 8 * HTB, NXCD = 8, WGM = 8;

__host__ __device__ __forceinline__ int lds_byte(int r, int c) { const int st = (r >> 4) * 2 + (c >> 5), rr = r & 15, cc = c & 31, ob = rr * 64 + cc * 2; return st * 1024 + (ob ^ (((ob >> 9) & 1) << 5)); }
__host__ __device__ __forceinline__ void stage_rc(int b, int& R, int& C) { const int st = b / 1024, sb = b % 1024, swz = sb ^ (((sb >> 9) & 1) << 5); R = (st >> 1) * 16 + swz / 64; C = (st & 1) * 32 + (swz % 64) / 2; }
__host__ __device__ __forceinline__ int perm32(int rho) { const int n = rho >> 4, i = rho & 15; return 8 * (i >> 2) + 4 * n + (i & 3); }

struct Unit { int pm, pn; };
struct Gemm { const bf16_t* A; const bf16_t* Bt; int M, N, K; };

struct StaticOrder {
    int nM, nN, nwg, G, c;
    __host__ __device__ void init(int M, int N, int G_, int c_) { nM = M / BM; nN = N / BM; nwg = nM * nN; G = G_; c = c_; }
    __host__ __device__ bool next(int i, Unit& u) const {
        const long L = (long)i * G + c; if (L >= nwg) return false;
        int wgid = (int)L; { const int q = nwg / NXCD, r = nwg % NXCD, xcd = wgid % NXCD, off = wgid / NXCD; wgid = (xcd < r ? xcd * (q + 1) : r * (q + 1) + (xcd - r) * q) + off; }
        const int nig = WGM * nN, gid = wgid / nig, fm = gid * WGM, gsz = (nM - fm) < WGM ? (nM - fm) : WGM;
        u.pm = fm + ((wgid % nig) % gsz); u.pn = (wgid % nig) / gsz; return true;
    }
    __device__ __forceinline__ void a_ready(const Unit&) const {}
    __device__ __forceinline__ void done(const Unit&) const {}
};
__device__ __forceinline__ unsigned cvt_pk_bf16(float lo, float hi) { unsigned r; asm volatile("v_cvt_pk_bf16_f32 %0, %1, %2" : "=v"(r) : "v"(lo), "v"(hi)); return r; }
typedef float f32x2 __attribute__((ext_vector_type(2)));
typedef unsigned u32x4e __attribute__((ext_vector_type(4)));
__device__ __forceinline__ float row_rs(const float* ssq, int row) {
    const f32x4* p = (const f32x4*)(ssq + (size_t)row * 16);
    const f32x4 a = p[0], b = p[1], c = p[2], d = p[3];
    const float s = (((a[0] + a[1]) + (a[2] + a[3])) + ((b[0] + b[1]) + (b[2] + b[3]))) + (((c[0] + c[1]) + (c[2] + c[3])) + ((d[0] + d[1]) + (d[2] + d[3])));
    return __builtin_amdgcn_rsqf(s * (1.0f / 1024.0f) + 1e-6f);
}
template <int NR> __device__ __forceinline__ void row_rsn(const float* ssq, int row0, int fq, float (&rs)[NR]) {
    f32x4 p[NR];
#pragma unroll
    for (int m = 0; m < NR; ++m) p[m] = *(const f32x4*)(ssq + (size_t)(row0 + 16 * m) * 16 + 4 * fq);
#pragma unroll
    for (int m = 0; m < NR; ++m) {
        float s = (p[m][0] + p[m][1]) + (p[m][2] + p[m][3]);
        s += __shfl_xor(s, 16); s += __shfl_xor(s, 32);
        rs[m] = __builtin_amdgcn_rsqf(s * (1.0f / 1024.0f) + 1e-6f);
    }
}
__device__ __forceinline__ float swiglu1(float g, float u) { return g * u * __builtin_amdgcn_rcpf(1.0f + __builtin_amdgcn_exp2f(g * -1.4426950408889634f)); }
struct EpiSwiGLU {
    static constexpr bool PERM = true, AFTER_DRAIN = false;
    bf16_t* O; const float* ssq; int ldo;
    __device__ __forceinline__ void operator()(const f32x4 (&acc)[2][2][4][2], const Unit& u, int wr, int wc, int fr, int fq) const {
        const int col0 = u.pn * 128 + wc * 32 + 8 * fq;
#pragma unroll
        for (int ai = 0; ai < 2; ++ai) {
            float rsv[4]; row_rsn<4>(ssq, u.pm * BM + ai * HALF + wr * 64 + fr, fq, rsv);
#pragma unroll
            for (int m = 0; m < 4; ++m) {
                const int row = u.pm * BM + ai * HALF + wr * 64 + m * 16 + fr;
                const float rs = rsv[m];
                const f32x4 g0 = acc[ai][0][m][0] * rs, g1 = acc[ai][0][m][1] * rs, u0 = acc[ai][1][m][0] * rs, u1 = acc[ai][1][m][1] * rs;
                u32x4e w;
                w.x = cvt_pk_bf16(swiglu1(g0[0], u0[0]), swiglu1(g0[1], u0[1])); w.y = cvt_pk_bf16(swiglu1(g0[2], u0[2]), swiglu1(g0[3], u0[3]));
                w.z = cvt_pk_bf16(swiglu1(g1[0], u1[0]), swiglu1(g1[1], u1[1])); w.w = cvt_pk_bf16(swiglu1(g1[2], u1[2]), swiglu1(g1[3], u1[3]));
                *(u32x4e*)(O + (size_t)row * ldo + col0) = w;
            }
        }
    }
};
struct EpiResid {
    static constexpr bool PERM = true, AFTER_DRAIN = false;
    bf16_t* hb; float* ssq; float alpha;
    __device__ __forceinline__ void operator()(const f32x4 (&acc)[2][2][4][2], const Unit& u, int wr, int wc, int fr, int fq) const {
        const int col0 = u.pn * BM + wc * 32 + 8 * fq;
#pragma unroll
        for (int ai = 0; ai < 2; ++ai) {
            u32x4e pre[4][2];
#pragma unroll
            for (int m = 0; m < 4; ++m)
#pragma unroll
                for (int bj = 0; bj < 2; ++bj) pre[m][bj] = *(const u32x4e*)(hb + (size_t)(u.pm * BM + ai * HALF + wr * 64 + m * 16 + fr) * 1024 + col0 + bj * HALF);
#pragma unroll
            for (int m = 0; m < 4; ++m) {
                const int row = u.pm * BM + ai * HALF + wr * 64 + m * 16 + fr;
                float s = 0.f;
#pragma unroll
                for (int bj = 0; bj < 2; ++bj) {
                    const size_t off = (size_t)row * 1024 + col0 + bj * HALF;
                    const u32x4e p = pre[m][bj];
                    const f32x4 r0 = {__uint_as_float(p.x << 16), __uint_as_float(p.x & 0xffff0000u), __uint_as_float(p.y << 16), __uint_as_float(p.y & 0xffff0000u)};
                    const f32x4 r1 = {__uint_as_float(p.z << 16), __uint_as_float(p.z & 0xffff0000u), __uint_as_float(p.w << 16), __uint_as_float(p.w & 0xffff0000u)};
                    const f32x4 v0 = r0 + acc[ai][bj][m][0] * alpha, v1 = r1 + acc[ai][bj][m][1] * alpha;
                    u32x4e w; w.x = cvt_pk_bf16(v0[0], v0[1]); w.y = cvt_pk_bf16(v0[2], v0[3]); w.z = cvt_pk_bf16(v1[0], v1[1]); w.w = cvt_pk_bf16(v1[2], v1[3]); *(u32x4e*)(hb + off) = w;
                    s += ((v0[0] * v0[0] + v0[1] * v0[1]) + (v0[2] * v0[2] + v0[3] * v0[3])) + ((v1[0] * v1[0] + v1[1] * v1[1]) + (v1[2] * v1[2] + v1[3] * v1[3]));
                }
                s += __shfl_xor(s, 16); s += __shfl_xor(s, 32);
                if (fq == 0) ssq[(size_t)row * 16 + u.pn * 4 + wc] = s;
            }
        }
    }
};
struct EpiProj {
    static constexpr bool PERM = true, AFTER_DRAIN = false;
    bf16_t* O0; size_t off1, off2; unsigned rot_mask, swz_mask; const float* ssq; const float* rope; float* kmp; float scale0;
    __device__ __forceinline__ void operator()(const f32x4 (&acc)[2][2][4][2], const Unit& u, int wr, int wc, int fr, int fq) const {
        const int sec = u.pn >> 2;
        size_t so = 0; if (sec >= 1) so += off1; if (sec >= 2) so += off2;
        bf16_t* dst = O0 + so;
        const bool rot = (((rot_mask >> sec) & 1u) != 0u) && ((wc & 1) == 0);
        const bool km = (kmp != nullptr) && (sec == 0);
        const bool swz = ((swz_mask >> sec) & 1u) != 0u;
        const int colS = (u.pn & 3) * BM + wc * 32 + 8 * fq;
        f32x4 ks[2][2];
#pragma unroll
        for (int bj = 0; bj < 2; ++bj)
#pragma unroll
            for (int n = 0; n < 2; ++n) ks[bj][n] = (f32x4){0.f, 0.f, 0.f, 0.f};
        const float sc = sec == 0 ? scale0 : 1.0f;
#pragma unroll
        for (int ai = 0; ai < 2; ++ai)
#pragma unroll
        for (int mp = 0; mp < 2; ++mp) {
            float rsv[2]; row_rsn<2>(ssq, u.pm * BM + ai * HALF + wr * 64 + mp * 32 + fr, fq, rsv);
            f32x4 rp4[2][4];
            if (rot) {
#pragma unroll
                for (int m2 = 0; m2 < 2; ++m2) { const f32x4* rp = (const f32x4*)(rope + (size_t)((u.pm * BM + ai * HALF + wr * 64 + (mp * 2 + m2) * 16 + fr) & 4095) * 16);
                    rp4[m2][0] = rp[0]; rp4[m2][1] = rp[1]; rp4[m2][2] = rp[2]; rp4[m2][3] = rp[3]; }
            }
#pragma unroll
            for (int m2 = 0; m2 < 2; ++m2) {
                const int m = mp * 2 + m2;
                const int row = u.pm * BM + ai * HALF + wr * 64 + m * 16 + fr;
                const float rs = rsv[m2] * sc;
                f32x4 cs[2], sn[2];
                if (rot) { cs[0] = rp4[m2][0]; cs[1] = rp4[m2][1]; sn[0] = rp4[m2][2]; sn[1] = rp4[m2][3]; }
#pragma unroll
                for (int bj = 0; bj < 2; ++bj) {
                    f32x4 v[2];
#pragma unroll
                    for (int n = 0; n < 2; ++n) {
                        v[n] = acc[ai][bj][m][n] * rs;
                        if (rot) {
                            f32x4 o;
#pragma unroll
                            for (int e = 0; e < 4; ++e) o[e] = __shfl_xor(v[n][e], 16);
                            if (fq == 0) v[n] = v[n] * cs[n] - o * sn[n];
                            else if (fq == 1) v[n] = o * sn[n] + v[n] * cs[n];
                        }
                        if (km) ks[bj][n] += v[n];
                    }
                    u32x4e w; w.x = cvt_pk_bf16(v[0][0], v[0][1]); w.y = cvt_pk_bf16(v[0][2], v[0][3]); w.z = cvt_pk_bf16(v[1][0], v[1][1]); w.w = cvt_pk_bf16(v[1][2], v[1][3]);
                    int col = colS + bj * HALF;
                    if (swz) { const int pp = row & 4095; col = ((((col >> 6) + pp) & 15) << 6) | (col & 63); }
                    *(u32x4e*)(dst + (size_t)row * 1024 + col) = w;
                }
            }
        }
        if (km) {
#pragma unroll
            for (int bj = 0; bj < 2; ++bj)
#pragma unroll
                for (int n = 0; n < 2; ++n) {
                    f32x4 t = ks[bj][n];
#pragma unroll
                    for (int e = 0; e < 4; ++e) { float x = t[e]; x += __shfl_xor(x, 1); x += __shfl_xor(x, 2); x += __shfl_xor(x, 4); x += __shfl_xor(x, 8); t[e] = x; }
                    if (fr == 0) *(f32x4*)(kmp + (size_t)(u.pm * 2 + wr) * 1024 + colS + bj * HALF + 4 * n) = t;
                }
        }
    }
};

template <class Epi, class Sched, bool ALIGN_EPI = false, bool SP2 = false>
__device__ __forceinline__ void gemm_phase(PG8_LAS unsigned char* lds, const Gemm g, const Sched& S, const Epi& E) {
    const int tid = threadIdx.x, wid = __builtin_amdgcn_readfirstlane(tid >> 6), lane = tid & 63, wr = wid >> 2, wc = wid & 3, fr = lane & 15, fq = lane >> 4;
    const int K = g.K, nt = K / BK;
    unsigned voffA[2], voffB[2];
#pragma unroll
    for (int i = 0; i < 2; ++i) { int R, C; stage_rc(tid * 16 + i * 8192, R, C); const int Rb = Epi::PERM ? ((R & ~31) + perm32(R & 31)) : R;
        voffA[i] = (unsigned)(R * K + C) * 2u; voffB[i] = (unsigned)(Rb * K + C) * 2u; }
    const size_t kstep = (size_t)(BK * 2);
    const size_t hstep = (size_t)HALF * K * 2;
    const size_t tstep = 2 * hstep;
    const unsigned ldsw = (unsigned)wid * 1024u;
    const int aoff = lds_byte(wr * 64 + fr, fq * 8), boff = lds_byte(wc * 32 + fr, fq * 8);
#define PG8_SA(b, h) (((b) * 2 + (h)) * HTB)
#define PG8_SB(b, h) ((4 + (b) * 2 + (h)) * HTB)
#define PG8_STAGE(bufoff, gbase, voff) do { _Pragma("unroll") for (int _i = 0; _i < 2; ++_i) \
        __builtin_amdgcn_global_load_lds((const unsigned*)((const char*)(gbase) + (voff)[_i]), (PG8_LAS unsigned*)(lds + (bufoff) + ldsw + _i * 8192), 16, 0, 0); } while (0)
#define PG8_LDA(dst, b, h) do { _Pragma("unroll") for (int m = 0; m < 4; ++m) _Pragma("unroll") for (int k = 0; k < 2; ++k) dst[m][k] = *(const PG8_LAS bf16x8*)(lds + PG8_SA(b, h) + aoff + m * 2048 + k * 1024); } while (0)
#define PG8_LDB(dst, b, h) do { _Pragma("unroll") for (int n = 0; n < 2; ++n) _Pragma("unroll") for (int k = 0; k < 2; ++k) dst[n][k] = *(const PG8_LAS bf16x8*)(lds + PG8_SB(b, h) + boff + n * 2048 + k * 1024); } while (0)
#define PG8_MMA(ai, bj, At, Bt) do { __builtin_amdgcn_s_setprio(1); _Pragma("unroll") for (int m = 0; m < 4; ++m) _Pragma("unroll") for (int n = 0; n < 2; ++n) _Pragma("unroll") for (int k = 0; k < 2; ++k) \
        acc[ai][bj][m][n] = __builtin_amdgcn_mfma_f32_16x16x32_bf16(Bt[n][k], At[m][k], acc[ai][bj][m][n], 0, 0, 0); __builtin_amdgcn_s_setprio(0); } while (0)
#define PG8_WAIT_V(n) asm volatile("s_waitcnt vmcnt(" #n ")" ::: "memory")
#define PG8_WAIT_L(n) asm volatile("s_waitcnt lgkmcnt(" #n ")" ::: "memory")
#define PG8_BAR __builtin_amdgcn_s_barrier()
#define PG8_SCHED __builtin_amdgcn_sched_barrier(0)
    Unit cur, nxt; int ui = 0;
    if (!S.next(0, cur)) return;
    f32x4 acc[2][2][4][2];
#pragma unroll
    for (int a = 0; a < 2; ++a)
#pragma unroll
        for (int b = 0; b < 2; ++b)
#pragma unroll
            for (int m = 0; m < 4; ++m)
#pragma unroll
                for (int n = 0; n < 2; ++n) acc[a][b][m][n] = (f32x4){0.f, 0.f, 0.f, 0.f};
    bf16x8 At[4][2], B0[2][2], B1[2][2];
    const char* cA = (const char*)g.A + (size_t)cur.pm * tstep; const char* cB = (const char*)g.Bt + (size_t)cur.pn * tstep;
    S.a_ready(cur);
    if constexpr (SP2) {
        PG8_STAGE(PG8_SB(0, 0), cB, voffB); PG8_STAGE(PG8_SB(0, 1), cB + hstep, voffB); PG8_STAGE(PG8_SA(0, 0), cA, voffA); PG8_STAGE(PG8_SA(0, 1), cA + hstep, voffA);
        if (wr == 1) PG8_BAR;
        PG8_WAIT_V(2); PG8_BAR;
        PG8_STAGE(PG8_SB(1, 0), cB + kstep, voffB); PG8_STAGE(PG8_SA(1, 0), cA + kstep, voffA); PG8_STAGE(PG8_SB(1, 1), cB + hstep + kstep, voffB);
        PG8_WAIT_V(6); PG8_BAR;
    } else {
        PG8_STAGE(PG8_SB(0, 0), cB, voffB); PG8_STAGE(PG8_SA(0, 0), cA, voffA); PG8_STAGE(PG8_SB(0, 1), cB + hstep, voffB); PG8_STAGE(PG8_SA(0, 1), cA + hstep, voffA);
        if (wr == 1) PG8_BAR;
        PG8_WAIT_V(4); PG8_BAR;
        PG8_STAGE(PG8_SB(1, 0), cB + kstep, voffB); PG8_STAGE(PG8_SA(1, 0), cA + kstep, voffA); PG8_STAGE(PG8_SB(1, 1), cB + hstep + kstep, voffB);
        PG8_WAIT_V(6); PG8_BAR;
    }
    for (;;) {
        const bool has_next = S.next(ui + 1, nxt);
        const char* nA = has_next ? (const char*)g.A + (size_t)nxt.pm * tstep : cA; const char* nB = has_next ? (const char*)g.Bt + (size_t)nxt.pn * tstep : cB;
        for (int t = 0; t < nt; t += 2) {
            const bool last = (t == nt - 2);
            const char* a1 = cA + (size_t)(t + 1) * kstep;
            const char* a2 = last ? nA : cA + (size_t)(t + 2) * kstep; const char* b2 = last ? nB : cB + (size_t)(t + 2) * kstep;
            const char* a3 = a2 + kstep; const char* b3 = b2 + kstep;
            if (last && has_next) S.a_ready(nxt);
            if constexpr (SP2) {
            PG8_LDB(B0, 0, 0); PG8_LDB(B1, 0, 1); PG8_SCHED; PG8_LDA(At, 0, 0); PG8_STAGE(PG8_SA(1, 1), a1 + hstep, voffA);
            PG8_WAIT_V(8); PG8_WAIT_L(0); PG8_BAR; PG8_MMA(0, 0, At, B0); PG8_MMA(0, 1, At, B1); PG8_BAR; PG8_SCHED;
            PG8_LDA(At, 0, 1); PG8_STAGE(PG8_SB(0, 0), b2, voffB); PG8_STAGE(PG8_SB(0, 1), b2 + hstep, voffB); PG8_STAGE(PG8_SA(0, 0), a2, voffA);
            PG8_WAIT_V(8); PG8_WAIT_L(0); PG8_BAR; PG8_MMA(1, 0, At, B0); PG8_MMA(1, 1, At, B1); PG8_BAR; PG8_SCHED;
            PG8_LDB(B0, 1, 0); PG8_LDB(B1, 1, 1); PG8_SCHED; PG8_LDA(At, 1, 0); PG8_STAGE(PG8_SA(0, 1), a2 + hstep, voffA);
            PG8_WAIT_V(8); PG8_WAIT_L(0); PG8_BAR; PG8_MMA(0, 0, At, B0); PG8_MMA(0, 1, At, B1); PG8_BAR; PG8_SCHED;
            PG8_LDA(At, 1, 1); PG8_STAGE(PG8_SB(1, 0), b3, voffB); PG8_STAGE(PG8_SB(1, 1), b3 + hstep, voffB); PG8_STAGE(PG8_SA(1, 0), a3, voffA);
            PG8_WAIT_V(8); PG8_WAIT_L(0); PG8_BAR; PG8_MMA(1, 0, At, B0); PG8_MMA(1, 1, At, B1); PG8_BAR; PG8_SCHED;
            } else {
            PG8_LDB(B0, 0, 0); PG8_SCHED; PG8_LDA(At, 0, 0); PG8_STAGE(PG8_SA(1, 1), a1 + hstep, voffA);
            PG8_WAIT_L(8); PG8_BAR; PG8_WAIT_L(0); PG8_MMA(0, 0, At, B0); PG8_BAR; PG8_SCHED;
            PG8_LDB(B1, 0, 1); PG8_STAGE(PG8_SB(0, 0), b2, voffB);
            PG8_BAR; PG8_WAIT_L(0); PG8_MMA(0, 1, At, B1); PG8_BAR;
            PG8_LDA(At, 0, 1); PG8_STAGE(PG8_SA(0, 0), a2, voffA);
            PG8_BAR; PG8_WAIT_L(0); PG8_MMA(1, 0, At, B0); PG8_BAR; PG8_SCHED;
            PG8_STAGE(PG8_SB(0, 1), b2 + hstep, voffB);
            PG8_WAIT_V(6); PG8_BAR; PG8_MMA(1, 1, At, B1); PG8_BAR;
            PG8_LDB(B0, 1, 0); PG8_SCHED; PG8_LDA(At, 1, 0); PG8_STAGE(PG8_SA(0, 1), a2 + hstep, voffA);
            PG8_WAIT_L(8); PG8_BAR; PG8_WAIT_L(0); PG8_MMA(0, 0, At, B0); PG8_BAR; PG8_SCHED;
            PG8_LDB(B1, 1, 1); PG8_STAGE(PG8_SB(1, 0), b3, voffB);
            PG8_BAR; PG8_WAIT_L(0); PG8_MMA(0, 1, At, B1); PG8_BAR;
            PG8_LDA(At, 1, 1); PG8_STAGE(PG8_SA(1, 0), a3, voffA);
            PG8_BAR; PG8_WAIT_L(0); PG8_MMA(1, 0, At, B0); PG8_BAR; PG8_SCHED;
            PG8_STAGE(PG8_SB(1, 1), b3 + hstep, voffB);
            PG8_WAIT_V(6); PG8_BAR; PG8_MMA(1, 1, At, B1); PG8_BAR;
            }
        }
        if constexpr (ALIGN_EPI) { if (wr == 0) PG8_BAR; }
        if constexpr (!Epi::AFTER_DRAIN) { E(acc, cur, wr, wc, fr, fq); S.done(cur); }
        if (!has_next) break;
#pragma unroll
        for (int a = 0; a < 2; ++a)
#pragma unroll
            for (int b = 0; b < 2; ++b)
#pragma unroll
                for (int m = 0; m < 4; ++m)
#pragma unroll
                    for (int n = 0; n < 2; ++n) acc[a][b][m][n] = (f32x4){0.f, 0.f, 0.f, 0.f};
        cur = nxt; cA = nA; cB = nB; ++ui;
        if constexpr (ALIGN_EPI) { if (wr == 1) PG8_BAR; }
    }
    PG8_WAIT_V(0);
    if constexpr (!ALIGN_EPI) { if (wr == 0) PG8_BAR; }
    PG8_BAR;
    if constexpr (Epi::AFTER_DRAIN) { E.fused(acc, cur, wr, wc, fr, fq, lds, wid, lane); S.done(cur); }
#undef PG8_SA
#undef PG8_SB
#undef PG8_STAGE
#undef PG8_LDA
#undef PG8_LDB
#undef PG8_MMA
#undef PG8_WAIT_V
#undef PG8_WAIT_L
#undef PG8_BAR
#undef PG8_SCHED
}
}

constexpr int NB = 8, SEQ = 4096, DM = 1024, NH = 16, HD = 64, FF = 2816, MROWS = NB * SEQ;
constexpr int NWAVES = 8;
constexpr size_t MiB = 1u << 20;
constexpr size_t WS_ROPE = 1 * MiB;
constexpr size_t WS_KMP = 2 * MiB;
constexpr size_t WS_KMEAN = 3 * MiB;
constexpr size_t WS_SSQ = 4 * MiB;
constexpr size_t WS_W = 8 * MiB;
constexpr size_t WS_HB = 96 * MiB;
constexpr size_t WS_ACT = 160 * MiB;
constexpr size_t WS_K = 336 * MiB, WS_V = 400 * MiB;
constexpr size_t WS_MP = 464 * MiB;
constexpr size_t WS_ML = 1 * MiB + 256 * 1024;
constexpr size_t WS_MM = 6 * MiB;
constexpr size_t WS_END = 512 * MiB;
constexpr size_t W_GU = (size_t)2 * FF * DM, W_D = (size_t)DM * FF, W_FFN = W_GU + W_D;
constexpr size_t WO_FFN = 0;
constexpr size_t WO_QKV = 4 * W_FFN, WO_AO = WO_QKV + (size_t)3 * DM * DM, WO_KV = WO_AO + (size_t)DM * DM, WO_BQ = WO_KV + (size_t)2 * DM * DM, WO_BO = WO_BQ + (size_t)DM * DM, WO_END = WO_BO + (size_t)DM * DM;
static_assert(WS_W + WO_END * 2 <= WS_HB, "weights fit");
constexpr int LDS_BYTES = 147456;

#define LAS __attribute__((address_space(3)))
typedef unsigned short bf16;
typedef short bf16x8 __attribute__((ext_vector_type(8)));
typedef short s16x4 __attribute__((ext_vector_type(4)));
typedef float f32x4 __attribute__((ext_vector_type(4)));
typedef float f32x16 __attribute__((ext_vector_type(16)));
typedef unsigned u32x4 __attribute__((ext_vector_type(4)));
typedef unsigned u32x2 __attribute__((ext_vector_type(2)));

__device__ __forceinline__ unsigned f2bf(float f) { unsigned u = __builtin_bit_cast(unsigned, f); return (u + 0x7fffu + ((u >> 16) & 1u)) >> 16; }
__device__ __forceinline__ unsigned pk2(float lo, float hi) { return f2bf(lo) | (f2bf(hi) << 16); }
__device__ __forceinline__ unsigned cvtpk(float lo, float hi) { return pg8::cvt_pk_bf16(lo, hi); }

constexpr float C2 = 0.125f * 1.4426950408889634f;
struct AttnState { f32x16 o0, o1; float m, l; };
typedef short v4i16_t __attribute__((ext_vector_type(4)));
__device__ __forceinline__ s16x4 vtr(const LAS char* p) { return __builtin_bit_cast(s16x4, __builtin_amdgcn_ds_read_tr16_b64_v4i16((LAS v4i16_t*)p)); }

__device__ __forceinline__ float xhalf_max(float v) { const auto rr = __builtin_amdgcn_permlane32_swap(__float_as_uint(v), __float_as_uint(v), false, false); return fmaxf(__uint_as_float(rr[0]), __uint_as_float(rr[1])); }
__device__ __forceinline__ float xhalf_sum(float v) { const auto rr = __builtin_amdgcn_permlane32_swap(__float_as_uint(v), __float_as_uint(v), false, false); return __uint_as_float(rr[0]) + __uint_as_float(rr[1]); }
constexpr float ATT_THR = 6.0f;
__device__ __forceinline__ void attn_stage(const u32x4 (&kg)[4], const u32x4 (&vg)[4], LAS char* kw, LAS char* vw) {
#pragma unroll
    for (int j = 0; j < 4; ++j) { *(LAS u32x4*)(kw + j * (8 * 144)) = kg[j]; *(LAS u32x4*)(vw + j * 512) = vg[j]; }
}
template <bool QLDS = false> __device__ __forceinline__ void attn_chunk2(AttnState (&st)[2], const bf16x8 (&qf)[2][4], const int (&D0)[2], const bool (&first)[2], const bool (&act)[2], const bool (&allornone)[2], const LAS char* kr, const LAS char* vr, const LAS char* qr = nullptr) {
    f32x16 s[2];
#pragma unroll
    for (int q = 0; q < 2; ++q) {
        const float negm = -st[q].m;
        if (allornone[q]) {
            const float bq = D0[q] > 0 ? negm : -INFINITY;
#pragma unroll
            for (int r = 0; r < 16; ++r) s[q][r] = bq;
        } else {
#pragma unroll
            for (int r = 0; r < 16; ++r) { const int delta = D0[q] - ((r & 3) + 8 * (r >> 2)); s[q][r] = ((unsigned)delta <= 128u) ? negm : -INFINITY; }
        }
    }
    asm volatile("s_waitcnt lgkmcnt(0)" ::: "memory");
    if (QLDS) {
#pragma unroll
        for (int q = 0; q < 2; ++q) if (act[q]) {
#pragma unroll
            for (int k = 0; k < 4; ++k) { const bf16x8 kv = *(const LAS bf16x8*)(kr + 32 * k), qv = *(const LAS bf16x8*)(qr + q * 4608 + 32 * k);
                s[q] = __builtin_amdgcn_mfma_f32_32x32x16_bf16(kv, qv, s[q], 0, 0, 0); }
        }
    } else {
        bf16x8 kf[4];
#pragma unroll
        for (int k = 0; k < 4; ++k) kf[k] = *(const LAS bf16x8*)(kr + 32 * k);
#pragma unroll
        for (int q = 0; q < 2; ++q) if (act[q]) {
#pragma unroll
            for (int k = 0; k < 4; ++k) s[q] = __builtin_amdgcn_mfma_f32_32x32x16_bf16(kf[k], qf[q][k], s[q], 0, 0, 0);
        }
    }
    s16x4 a[2][2][2];
#define VT(dt, k) (bf16x8){a[dt][k][0][0], a[dt][k][0][1], a[dt][k][0][2], a[dt][k][0][3], a[dt][k][1][0], a[dt][k][1][1], a[dt][k][1][2], a[dt][k][1][3]}
#pragma unroll
    for (int q = 0; q < 2; ++q) {
        bf16x8 pb0 = {}, pb1 = {};
        if (act[q]) {
            float t = fmaxf(fmaxf(s[q][0], s[q][1]), s[q][2]);
#pragma unroll
            for (int r = 3; r < 15; r += 2) t = fmaxf(fmaxf(t, s[q][r]), s[q][r + 1]);
            t = fmaxf(t, s[q][15]);
            t = xhalf_max(t);
            if (first[q] || __builtin_amdgcn_ballot_w64(t > ATT_THR) != 0ull) {
                const float delta = first[q] ? t : fmaxf(t, 0.f);
                st[q].m += delta;
                const float alpha = __builtin_amdgcn_exp2f(-delta);
#pragma unroll
                for (int r = 0; r < 16; ++r) s[q][r] -= delta;
                st[q].l *= alpha; st[q].o0 *= alpha; st[q].o1 *= alpha;
            }
            float ps0 = 0.f, ps1 = 0.f;
#pragma unroll
            for (int r = 0; r < 16; r += 2) { s[q][r] = __builtin_amdgcn_exp2f(s[q][r]); s[q][r + 1] = __builtin_amdgcn_exp2f(s[q][r + 1]); ps0 += s[q][r]; ps1 += s[q][r + 1]; }
            st[q].l += ps0 + ps1;
            u32x4 p0, p1;
            p0.x = cvtpk(s[q][0], s[q][1]); p0.y = cvtpk(s[q][2], s[q][3]); p0.z = cvtpk(s[q][4], s[q][5]); p0.w = cvtpk(s[q][6], s[q][7]);
            p1.x = cvtpk(s[q][8], s[q][9]); p1.y = cvtpk(s[q][10], s[q][11]); p1.z = cvtpk(s[q][12], s[q][13]); p1.w = cvtpk(s[q][14], s[q][15]);
            pb0 = __builtin_bit_cast(bf16x8, p0); pb1 = __builtin_bit_cast(bf16x8, p1);
        }
        if (q == 0) {
#pragma unroll
            for (int dt = 0; dt < 2; ++dt)
#pragma unroll
                for (int k = 0; k < 2; ++k) { a[dt][k][0] = vtr(vr + dt * 2048 + k * 1024); a[dt][k][1] = vtr(vr + dt * 2048 + k * 1024 + 512); }
            asm volatile("s_waitcnt lgkmcnt(0)" ::: "memory");
        }
        if (act[q]) {
            st[q].o0 = __builtin_amdgcn_mfma_f32_32x32x16_bf16(VT(0, 0), pb0, st[q].o0, 0, 0, 0);
            st[q].o1 = __builtin_amdgcn_mfma_f32_32x32x16_bf16(VT(1, 0), pb0, st[q].o1, 0, 0, 0);
            st[q].o0 = __builtin_amdgcn_mfma_f32_32x32x16_bf16(VT(0, 1), pb1, st[q].o0, 0, 0, 0);
            st[q].o1 = __builtin_amdgcn_mfma_f32_32x32x16_bf16(VT(1, 1), pb1, st[q].o1, 0, 0, 0);
        }
    }
#undef VT
}
__device__ __forceinline__ void attn_store(const AttnState& st, bf16* orow, int hi) {
    const float lt = xhalf_sum(st.l);
    const float inv = 1.0f / lt;
#pragma unroll
    for (int g = 0; g < 4; ++g) {
        u32x2 w0, w1;
        w0.x = cvtpk(st.o0[4 * g] * inv, st.o0[4 * g + 1] * inv); w0.y = cvtpk(st.o0[4 * g + 2] * inv, st.o0[4 * g + 3] * inv);
        w1.x = cvtpk(st.o1[4 * g] * inv, st.o1[4 * g + 1] * inv); w1.y = cvtpk(st.o1[4 * g + 2] * inv, st.o1[4 * g + 3] * inv);
        *(u32x2*)(orow + 8 * g + 4 * hi) = w0; *(u32x2*)(orow + 32 + 8 * g + 4 * hi) = w1;
    }
}
__device__ __forceinline__ void attn_load_kv(u32x4 (&kg)[4], u32x4 (&vg)[4], const bf16* K, const bf16* V, size_t rowb, int p0, int pstep, int h, int lane) {
#pragma unroll
    for (int j = 0; j < 4; ++j) { const int pj = p0 + j * pstep; const size_t off = (rowb + pj) * DM + h * HD + 8 * (lane & 7);
        kg[j] = *(const u32x4*)(K + off); vg[j] = *(const u32x4*)(V + off); }
}

__device__ __forceinline__ void dil_desc(int ci, int c, int r16, int n16, int n4, int& d, int& r, int& u0) {
    if (ci < n16) { d = 16; r = r16; u0 = 32 * (c - ci); }
    else if (ci < n16 + n4) { d = 4; r = r16 & 3; u0 = 128 * c + 96 - 32 * (ci - n16); }
    else { d = 1; r = 0; u0 = 512 * c + 480 - 32 * (ci - n16 - n4); }
}
#define ATT_LOOP(NTOT, LOADK, COMPUTE) do { \
    u32x4 kA[4], vA[4]; \
    LOADK(kA, vA, 0); \
    for (int ci = 0; ci < (NTOT); ++ci) { \
        attn_stage(kA, vA, kw, vw); \
        if (ci + 1 < (NTOT)) LOADK(kA, vA, ci + 1); \
        COMPUTE(ci); \
    } } while (0)

__device__ __forceinline__ void dil_desc2(int ci, int c, int r16a, int n16, int n4, int& d, int& r, int& u0, int& who) {
    if (ci < n16) { d = 16; r = r16a; u0 = 32 * (c - ci); who = 0; }
    else if (ci < 2 * n16) { d = 16; r = r16a + 8; u0 = 32 * (c - (ci - n16)); who = 1; }
    else if (ci < 2 * n16 + n4) { d = 4; r = r16a & 3; u0 = 128 * c + 96 - 32 * (ci - 2 * n16); who = 2; }
    else { d = 1; r = 0; u0 = 512 * c + 480 - 32 * (ci - 2 * n16 - n4); who = 2; }
}
__device__ __forceinline__ void dilated_phase(LAS unsigned char* lds, const bf16* Q, const bf16* K, const bf16* V, bf16* O, int vcu, int G) {
    const int tid = threadIdx.x, lane = tid & 63, wid = __builtin_amdgcn_readfirstlane(tid >> 6), hi = lane >> 5, qi = lane & 31;
    LAS char* wbase = (LAS char*)lds + wid * 8704;
    LAS char* kw = wbase + (lane >> 3) * 144 + (lane & 7) * 16;
    const LAS char* kr = wbase + qi * 144 + hi * 16;
    LAS char* vw = wbase + 4608 + ((lane & 7) >> 2) * 2048 + (lane >> 3) * 64 + (lane & 3) * 16;
    const LAS char* vr = wbase + 4608 + ((lane >> 4) & 1) * 32 + (lane & 3) * 8 + (4 * hi + ((lane & 15) >> 2)) * 64;
    for (int g = vcu; g < NB * NH * 8; g += G) {
        const int bh = g >> 3, c = ((g & 7) + 2 * (g / G)) & 7;
        const int b = bh >> 4, h = bh & 15;
        const size_t rowb = (size_t)b * SEQ;
        const int n16 = (c < 4 ? c : 4) + 1, n4 = c == 0 ? 4 : 8, n1 = c == 0 ? 16 : 20, ntot = 2 * n16 + n4 + n1;
        const int r16a = wid;
        bf16x8 qf[2][4];
#pragma unroll
        for (int q = 0; q < 2; ++q) { const bf16* qp = Q + (rowb + 512 * c + r16a + 8 * q + 16 * qi) * DM + h * HD + 8 * hi;
#pragma unroll
            for (int k = 0; k < 4; ++k) qf[q][k] = *(const bf16x8*)(qp + 16 * k); }
        AttnState st[2];
#pragma unroll
        for (int q = 0; q < 2; ++q) { st[q].o0 = f32x16{}; st[q].o1 = f32x16{}; st[q].m = 0.f; st[q].l = 0.f; }
#define DIL_LOAD(kx, vx, idx) do { int d_, r_, u0_, who_; dil_desc2((idx), c, r16a, n16, n4, d_, r_, u0_, who_); \
            attn_load_kv(kx, vx, K, V, rowb, (u0_ + (lane >> 3)) * d_ + r_, 8 * d_, h, lane); } while (0)
#define DIL_COMP(idx) do { int d_, r_, u0_, who_; dil_desc2((idx), c, r16a, n16, n4, d_, r_, u0_, who_); \
              \
            const int Wa_ = d_ == 16 ? 32 * c + qi : (d_ == 4 ? 128 * c + (r16a >> 2) + 4 * qi : 512 * c + r16a + 16 * qi); \
            const int Wb_ = d_ == 16 ? 32 * c + qi : (d_ == 4 ? 128 * c + (r16a >> 2) + 2 + 4 * qi : 512 * c + r16a + 8 + 16 * qi); \
            const int D0_[2] = {Wa_ - u0_ - 4 * hi, Wb_ - u0_ - 4 * hi}; \
            const bool first_[2] = {(idx) == 0, (idx) == n16}; const bool act_[2] = {who_ != 1, who_ != 0}; \
            const int kk_ = who_ == 0 ? (idx) : (idx) - n16; const bool in_ = who_ != 2 && kk_ >= 1 && kk_ <= 3;        \
            const bool aon_[2] = {in_, in_}; \
            attn_chunk2(st, qf, D0_, first_, act_, aon_, kr, vr); } while (0)
        ATT_LOOP(ntot, DIL_LOAD, DIL_COMP);
#undef DIL_LOAD
#undef DIL_COMP
#pragma unroll
        for (int q = 0; q < 2; ++q) attn_store(st[q], O + (rowb + 512 * c + r16a + 8 * q + 16 * qi) * DM + h * HD, hi);
    }
}

constexpr int MC_WAVE = 8704 + 2 * 4608, MC_ACC = 0, MC_ROW = 68, MC_CNT = 8 * MC_WAVE, MC_LIST = MC_CNT + 512, MC_END = MC_LIST + 768 * 4;
#define WG_BAR() asm volatile("s_waitcnt lgkmcnt(0)\n\ts_barrier" ::: "memory")
__device__ __forceinline__ unsigned moba_gate3(const bf16x8 (&qf)[4], const float* kmean, int b, int h, int hi, int own) {
    float g0 = -INFINITY, g1 = -INFINITY, g2 = -INFINITY; int i0 = -1, i1 = -1, i2 = -1;
    for (int n = 0; n < own; n += 2) {
        f32x4 kv[2][8];
#pragma unroll
        for (int j = 0; j < 2; ++j) {
            const float* km = kmean + (size_t)(b * 16 + n) * DM + h * HD + 8 * hi + ((j == 1 && n + 1 < own) ? DM : 0);
#pragma unroll
            for (int k = 0; k < 4; ++k) { kv[j][2 * k] = *(const f32x4*)(km + 16 * k); kv[j][2 * k + 1] = *(const f32x4*)(km + 16 * k + 4); }
        }
#pragma unroll
        for (int j = 0; j < 2; ++j) {
            float acc = 0.f;
#pragma unroll
            for (int k = 0; k < 4; ++k) {
#pragma unroll
                for (int e = 0; e < 4; ++e) {
                    acc += __uint_as_float(((unsigned)(unsigned short)qf[k][e]) << 16) * kv[j][2 * k][e];
                    acc += __uint_as_float(((unsigned)(unsigned short)qf[k][4 + e]) << 16) * kv[j][2 * k + 1][e];
                }
            }
            const float gt = xhalf_sum(acc);
            const int nj = n + j;
            if (nj < own) {
                if (gt > g0) { g2 = g1; i2 = i1; g1 = g0; i1 = i0; g0 = gt; i0 = nj; }
                else if (gt > g1) { g2 = g1; i2 = i1; g1 = gt; i1 = nj; }
                else if (gt > g2) { g2 = gt; i2 = nj; }
            }
        }
    }
    return (unsigned)(i0 + 1) | ((unsigned)(i1 + 1) << 8) | ((unsigned)(i2 + 1) << 16);
}
__device__ __forceinline__ void moba_phase(LAS unsigned char* lds, const bf16* Q, const bf16* K, const bf16* V, const float* kmean, bf16* O, float* mp, float* ml, float* mm, int vcu, int G) {
    const int tid = threadIdx.x, lane = tid & 63, wid = __builtin_amdgcn_readfirstlane(tid >> 6), hi = lane >> 5, qi = lane & 31;
    LAS char* wbase = (LAS char*)lds + wid * MC_WAVE;
    LAS char* qr = wbase + 8704 + qi * 144 + hi * 16;
    LAS char* kw = wbase + (lane >> 3) * 144 + (lane & 7) * 16;
    const LAS char* kr = wbase + qi * 144 + hi * 16;
    LAS char* vw = wbase + 4608 + ((lane & 7) >> 2) * 2048 + (lane >> 3) * 64 + (lane & 3) * 16;
    const LAS char* vr = wbase + 4608 + ((lane >> 4) & 1) * 32 + (lane & 3) * 8 + (4 * hi + ((lane & 15) >> 2)) * 64;
    LAS float* acc = (LAS float*)(lds + MC_ACC);
    volatile LAS unsigned* cnt = (volatile LAS unsigned*)(lds + MC_CNT);
    volatile LAS unsigned* list = (volatile LAS unsigned*)(lds + MC_LIST);
    const int ql = 32 * wid + qi;
    const unsigned ltm = (1u << qi) - 1u;
    int jj = 0;
    for (int u = vcu; u < NB * NH * 16; u += G, ++jj) {
        const int bh = u >> 4, o = (jj & 1) ? 15 - (u & 15) : (u & 15), b = bh >> 4, h = bh & 15;
        const size_t rowb = (size_t)b * SEQ;
        bf16x8 qf[2][4];
        { const bf16* qp = Q + (rowb + 256 * o + ql) * DM + h * HD + 8 * hi;
#pragma unroll
          for (int k = 0; k < 4; ++k) qf[0][k] = *(const bf16x8*)(qp + 16 * k); }
        const unsigned sbp = moba_gate3(qf[0], kmean, b, h, hi, o);
#define sb0 ((int)(sbp & 255u) - 1)
#define sb1 ((int)((sbp >> 8) & 255u) - 1)
#define sb2 ((int)((sbp >> 16) & 255u) - 1)
        AttnState st[2];
        WG_BAR();
        int pos0 = 0, pos1 = 0, pos2 = 0;
        for (int n = 0; n < o; ++n) {
            const unsigned b0 = (unsigned)__builtin_amdgcn_ballot_w64(sb0 == n), b1 = (unsigned)__builtin_amdgcn_ballot_w64(sb1 == n), b2 = (unsigned)__builtin_amdgcn_ballot_w64(sb2 == n);
            const int c0 = __builtin_popcount(b0), c1 = __builtin_popcount(b1), c2 = __builtin_popcount(b2);
            if (lane == 0) cnt[n * 8 + wid] = (unsigned)(c0 + c1 + c2);
            if (sb0 == n) pos0 = __builtin_popcount(b0 & ltm);
            if (sb1 == n) pos1 = c0 + __builtin_popcount(b1 & ltm);
            if (sb2 == n) pos2 = c0 + c1 + __builtin_popcount(b2 & ltm);
        }
        WG_BAR();
        { int pre = 0, base0 = 0, base1 = 0, base2 = 0;
          for (int n = 0; n < o; ++n) {
              int cb = 0, cl = 0;
#pragma unroll
              for (int w2 = 0; w2 < 8; ++w2) { const int cv = (int)cnt[n * 8 + w2]; cb += cv; if (w2 < wid) cl += cv; }
              if (sb0 == n) base0 = pre + cl;
              if (sb1 == n) base1 = pre + cl;
              if (sb2 == n) base2 = pre + cl;
              pre += cb;
          }
          if (hi == 0) {
              if (sb0 >= 0) list[base0 + pos0] = (unsigned)ql;
              if (sb1 >= 0) list[base1 + pos1] = (unsigned)ql | 256u;
              if (sb2 >= 0) list[base2 + pos2] = (unsigned)ql | 512u; } }
        WG_BAR();
        int pbase = 0, lbase = 0;
        for (int n = 0; n < o; ++n) {
            int c = 0;
#pragma unroll
            for (int w2 = 0; w2 < 8; ++w2) c += (int)cnt[n * 8 + w2];
            c = __builtin_amdgcn_readfirstlane(c);
            const int T = (c + 31) >> 5, NP = (T + 1) >> 1;
            for (int pi = 0; pi < NP; ++pi) {
                if (((pbase + pi) & 7) != wid) continue;
                const bool two = 2 * pi + 1 < T;
                { const int e0 = 64 * pi + qi, e1 = 64 * pi + 32 + qi;
                  const bool v0 = e0 < c, v1 = two && (e1 < c);
                  const int qs0 = (int)(list[lbase + (v0 ? e0 : 64 * pi)] & 255u), qs1 = (int)(list[lbase + (v1 ? e1 : (two ? 64 * pi + 32 : 64 * pi))] & 255u);
                  const bf16* qp0 = Q + (rowb + 256 * o + qs0) * DM + h * HD + 8 * hi; const bf16* qp1 = Q + (rowb + 256 * o + qs1) * DM + h * HD + 8 * hi;
                  bf16x8 t0[4], t1[4];
#pragma unroll
                  for (int kk = 0; kk < 4; ++kk) { t0[kk] = *(const bf16x8*)(qp0 + 16 * kk); t1[kk] = *(const bf16x8*)(qp1 + 16 * kk); }
#pragma unroll
                  for (int kk = 0; kk < 4; ++kk) { *(LAS bf16x8*)(qr + 32 * kk) = t0[kk]; *(LAS bf16x8*)(qr + 4608 + 32 * kk) = t1[kk]; } }
#pragma unroll
                for (int q = 0; q < 2; ++q) { st[q].o0 = f32x16{}; st[q].o1 = f32x16{}; st[q].m = 0.f; st[q].l = 0.f; }
#define MP_LOAD(kx, vx, idx) attn_load_kv(kx, vx, K, V, rowb, 256 * n + 32 * (idx) + (lane >> 3), 8, h, lane)
#define MP_COMP(idx) do { const int D0_[2] = {64, 64}; const bool first_[2] = {(idx) == 0, (idx) == 0}; const bool act_[2] = {true, two}; const bool aon_[2] = {true, true}; \
                    attn_chunk2<true>(st, qf, D0_, first_, act_, aon_, kr, vr, qr); } while (0)
                ATT_LOOP(8, MP_LOAD, MP_COMP);
#undef MP_LOAD
#undef MP_COMP
                const int e0 = 64 * pi + qi, e1 = 64 * pi + 32 + qi;
                const bool v0 = e0 < c, v1 = two && (e1 < c);
                const unsigned en0 = list[lbase + (v0 ? e0 : 64 * pi)], en1 = list[lbase + (v1 ? e1 : (two ? 64 * pi + 32 : 64 * pi))];
                const int qs0 = (int)(en0 & 255u), rk0 = (int)(en0 >> 8), qs1 = (int)(en1 & 255u), rk1 = (int)(en1 >> 8);
                const float lt0 = xhalf_sum(st[0].l), lt1 = xhalf_sum(st[1].l);
                const float f0 = 1.0f, f1 = 1.0f;
                if (v0) { float* d = mp + (size_t)(qs0 * 3 + rk0) * 64;
#pragma unroll
                    for (int g = 0; g < 4; ++g) {
                        *(f32x4*)(d + 8 * g + 4 * hi) = (f32x4){st[0].o0[4 * g], st[0].o0[4 * g + 1], st[0].o0[4 * g + 2], st[0].o0[4 * g + 3]} * f0;
                        *(f32x4*)(d + 32 + 8 * g + 4 * hi) = (f32x4){st[0].o1[4 * g], st[0].o1[4 * g + 1], st[0].o1[4 * g + 2], st[0].o1[4 * g + 3]} * f0; }
                    if (hi == 0) { ml[qs0 * 3 + rk0] = lt0 * f0; mm[qs0 * 3 + rk0] = st[0].m; } }
                if (v1) { float* d = mp + (size_t)(qs1 * 3 + rk1) * 64;
#pragma unroll
                    for (int g = 0; g < 4; ++g) {
                        *(f32x4*)(d + 8 * g + 4 * hi) = (f32x4){st[1].o0[4 * g], st[1].o0[4 * g + 1], st[1].o0[4 * g + 2], st[1].o0[4 * g + 3]} * f1;
                        *(f32x4*)(d + 32 + 8 * g + 4 * hi) = (f32x4){st[1].o1[4 * g], st[1].o1[4 * g + 1], st[1].o1[4 * g + 2], st[1].o1[4 * g + 3]} * f1; }
                    if (hi == 0) { ml[qs1 * 3 + rk1] = lt1 * f1; mm[qs1 * 3 + rk1] = st[1].m; } }
            }
            pbase += NP; lbase += c;
        }
        { const bf16* qp = Q + (rowb + 256 * o + ql) * DM + h * HD + 8 * hi;
#pragma unroll
          for (int k = 0; k < 4; ++k) qf[0][k] = *(const bf16x8*)(qp + 16 * k); }
#pragma unroll
        for (int q = 0; q < 2; ++q) { st[q].o0 = f32x16{}; st[q].o1 = f32x16{}; st[q].m = 0.f; st[q].l = 0.f; }
#pragma unroll
        for (int k = 0; k < 4; ++k) qf[1][k] = qf[0][k];
#define MC_LOAD(kx, vx, idx) attn_load_kv(kx, vx, K, V, rowb, 256 * o + 32 * (wid - (idx)) + (lane >> 3), 8, h, lane)
#define MC_COMP(idx) do { const int D0_[2] = {(idx) == 0 ? qi - 4 * hi : 64, 0}; const bool first_[2] = {(idx) == 0, false}; const bool act_[2] = {true, false}; const bool aon_[2] = {(idx) != 0, true}; \
            attn_chunk2(st, qf, D0_, first_, act_, aon_, kr, vr); } while (0)
        ATT_LOOP(wid + 1, MC_LOAD, MC_COMP);
#undef MC_LOAD
#undef MC_COMP
        asm volatile("s_waitcnt vmcnt(0)" ::: "memory");
        WG_BAR();
        __builtin_amdgcn_fence(__ATOMIC_ACQUIRE, "agent");
        { int qlu = ql; asm volatile("" : "+v"(qlu));
          float lsum = xhalf_sum(st[0].l); const float mq = st[0].m;
          f32x4 a0[4], a1[4];
#pragma unroll
          for (int g = 0; g < 4; ++g) { a0[g] = (f32x4){st[0].o0[4 * g], st[0].o0[4 * g + 1], st[0].o0[4 * g + 2], st[0].o0[4 * g + 3]}; a1[g] = (f32x4){st[0].o1[4 * g], st[0].o1[4 * g + 1], st[0].o1[4 * g + 2], st[0].o1[4 * g + 3]}; }
#pragma unroll
          for (int j = 0; j < 3; ++j) { const int sbj = j == 0 ? sb0 : (j == 1 ? sb1 : sb2);
              if (sbj >= 0) { const float* d = mp + (size_t)(qlu * 3 + j) * 64; const float fj = __builtin_amdgcn_exp2f(mm[qlu * 3 + j] - mq);
#pragma unroll
                  for (int g = 0; g < 4; ++g) { a0[g] += *(const f32x4*)(d + 8 * g + 4 * hi) * fj; a1[g] += *(const f32x4*)(d + 32 + 8 * g + 4 * hi) * fj; }
                  lsum += ml[qlu * 3 + j] * fj; } }
          const float inv = 1.0f / lsum;
          bf16* orow = O + (rowb + 256 * o + qlu) * DM + h * HD;
#pragma unroll
          for (int g = 0; g < 4; ++g) {
              const f32x4 v0 = a0[g] * inv, v1 = a1[g] * inv;
              u32x2 w0, w1; w0.x = cvtpk(v0[0], v0[1]); w0.y = cvtpk(v0[2], v0[3]); w1.x = cvtpk(v1[0], v1[1]); w1.y = cvtpk(v1[2], v1[3]);
              *(u32x2*)(orow + 8 * g + 4 * hi) = w0; *(u32x2*)(orow + 32 + 8 * g + 4 * hi) = w1; } }
    }
}
#define XB_TMO      128
#define XB_XCNT(j)  (256  + 64 * (j))
#define XB_XSUB(j)  (1280 + 64 * (j))
#define XB_XGEN(j)  (2304 + 64 * (j))
#define XB_TOP      3328
#define XB_TOPGEN   3392
#define XCD_BAR_WORDS 3456
#define XB_SPIN_CAP (1u << 18)

__device__ __forceinline__ unsigned xb_ld(unsigned* p)              { return __hip_atomic_load(p, __ATOMIC_RELAXED, __HIP_MEMORY_SCOPE_AGENT); }
__device__ __forceinline__ unsigned xb_add(unsigned* p, unsigned v) { return __hip_atomic_fetch_add(p, v, __ATOMIC_RELAXED, __HIP_MEMORY_SCOPE_AGENT); }
__device__ __forceinline__ unsigned xb_xcc_id() { return (unsigned)__builtin_amdgcn_s_getreg((3 << 11) | 20) & 0xFu; }
#define XB_SPIN(cond, bar) do { unsigned _sp = 0; while (cond) { __builtin_amdgcn_s_sleep(1); \
    if ((++_sp & 255u) == 0u) { if (xb_ld(&(bar)[XB_TMO])) break; if (_sp > XB_SPIN_CAP) { atomicAdd(&(bar)[XB_TMO], 1u); break; } } } } while (0)

struct XcdBarrier {
    unsigned* bar; unsigned x;
    volatile LAS unsigned* st;
};

__device__ __forceinline__ XcdBarrier xcd_barrier_post(unsigned* bar, volatile LAS unsigned* st) {
    XcdBarrier b; b.bar = bar; b.x = xb_xcc_id(); b.st = st;
    if (threadIdx.x == 0) (void)xb_add(&bar[XB_XCNT(b.x)], 1u);
    return b;
}
__device__ __forceinline__ void xcd_barrier_complete(unsigned* bar, unsigned x, unsigned& nloc, unsigned& nx) {
    const unsigned G = gridDim.x * gridDim.y * gridDim.z;
    unsigned sum, cnt, mine, sp = 0u;
    for (;;) {
        sum = 0u; cnt = 0u; mine = 0u;
#pragma unroll
        for (unsigned j = 0; j < 16; ++j) { const unsigned c = xb_ld(&bar[XB_XCNT(j)]); sum += c; cnt += (c > 0u) ? 1u : 0u; mine = (j == x) ? c : mine; }
        if (sum == G) break;
        __builtin_amdgcn_s_sleep(1);
        if ((++sp & 255u) == 0u) { if (xb_ld(&bar[XB_TMO])) break; if (sp > XB_SPIN_CAP) { atomicAdd(&bar[XB_TMO], 1u); break; } }
    }
    nloc = mine > 0u ? mine : 1u; nx = cnt > 0u ? cnt : 1u;
}

__device__ __forceinline__ void xcd_barrier(const XcdBarrier& b) {
    asm volatile("s_waitcnt vmcnt(0)" ::: "memory");
    __syncthreads();
    if (threadIdx.x == 0) {
        unsigned* bar = b.bar;
        __builtin_amdgcn_s_waitcnt(0);
        unsigned nloc = b.st[0], nx = b.st[1];
        if (nloc == 0u) { xcd_barrier_complete(bar, b.x, nloc, nx); b.st[0] = nloc; b.st[1] = nx; }
        const unsigned old = xb_add(&bar[XB_XSUB(b.x)], 1u);
        const unsigned gen = old / nloc;
        if (old + 1u == (gen + 1u) * nloc) {
            __builtin_amdgcn_fence(__ATOMIC_RELEASE, "agent");
            asm volatile("s_waitcnt vmcnt(0)" ::: "memory");
            const unsigned og = xb_add(&bar[XB_TOP], 1u);
            const unsigned tg = og / nx;
            if (og + 1u == (tg + 1u) * nx) xb_add(&bar[XB_TOPGEN], 1u);
            else XB_SPIN(xb_ld(&bar[XB_TOPGEN]) == tg, bar);
            __builtin_amdgcn_fence(__ATOMIC_ACQUIRE, "agent");
            xb_add(&bar[XB_XGEN(b.x)], 1u);
            asm volatile("s_waitcnt vmcnt(0)" ::: "memory");
        } else {
            XB_SPIN(xb_ld(&bar[XB_XGEN(b.x)]) == gen, bar);
            __builtin_amdgcn_fence(__ATOMIC_ACQUIRE, "agent");
            asm volatile("s_waitcnt vmcnt(0)" ::: "memory");
        }
    }
    __syncthreads();
}

__device__ __forceinline__ float wave_sum(float v) {
#pragma unroll
    for (int o = 1; o < 64; o <<= 1) v += __shfl_xor(v, o);
    return v;
}
__device__ __forceinline__ void transpose_item(const float* W, const float* gain, int K, int N, bf16* WT, int k0, int n0, int dst_row0, LAS float* scr, int lane) {
    f32x4 wv[8];
#pragma unroll
    for (int i = 0; i < 8; ++i) wv[i] = *(const f32x4*)(W + (size_t)(k0 + 8 * i + (lane >> 3)) * N + n0 + 4 * (lane & 7));
#pragma unroll
    for (int i = 0; i < 8; ++i) { const int kk = 8 * i + (lane >> 3); f32x4 w = wv[i]; if (gain) w = w * gain[k0 + kk];
#pragma unroll
        for (int e = 0; e < 4; ++e) scr[kk * 33 + 4 * (lane & 7) + e] = w[e]; }
    asm volatile("s_waitcnt lgkmcnt(0)" ::: "memory");
    const int c = lane & 7;
#pragma unroll
    for (int j = 0; j < 4; ++j) { const int n = (lane >> 3) + 8 * j; const LAS float* s = scr + (8 * c) * 33 + n;
        u32x4 o; o.x = pk2(s[0 * 33], s[1 * 33]); o.y = pk2(s[2 * 33], s[3 * 33]); o.z = pk2(s[4 * 33], s[5 * 33]); o.w = pk2(s[6 * 33], s[7 * 33]);
        *(u32x4*)(WT + (size_t)(dst_row0 + n) * K + k0 + 8 * c) = o; }
    asm volatile("s_waitcnt lgkmcnt(0)" ::: "memory");
}

#ifndef REP_P0
#define REP_P0 1
#endif
#ifndef REP_P1
#define REP_P1 1
#endif
#ifndef REP_P4
#define REP_P4 1
#endif
#ifndef REP_P11
#define REP_P11 1
#endif
#ifndef REP_P2
#define REP_P2 1
#endif
#ifndef REP_P3
#define REP_P3 1
#endif
struct Args { const float* in[17]; float* out; unsigned char* ws; int ph_lo, ph_hi; };
static_assert(sizeof(Args) == 17 * 8 + 8 + 8 + 8, "no padding bytes in Args");
enum { IN_X = 0, IN_F1N, IN_F1G, IN_F1U, IN_F1D, IN_MIXN, IN_F2N, IN_F2G, IN_F2U, IN_F2D, IN_AQKV, IN_AO, IN_KVN, IN_KVW, IN_BQ, IN_BO, IN_FINN };
constexpr int N_PHASES = 16;

__global__ void __launch_bounds__(NWAVES * 64, 2) fwd_kernel(Args args) {
    extern __shared__ __attribute__((aligned(16))) unsigned char lds_raw[];
    LAS unsigned char* lds = (LAS unsigned char*)lds_raw;
    const int tid = threadIdx.x, lane = tid & 63, wave = __builtin_amdgcn_readfirstlane(tid >> 6);
    const int G = gridDim.x, bx = blockIdx.x;
    const int vcu = (G % 8 == 0) ? (bx % 8) * (G / 8) + bx / 8 : bx;
    unsigned char* ws = args.ws;
    float* rope = (float*)(ws + WS_ROPE); float* kmp = (float*)(ws + WS_KMP); float* kmean = (float*)(ws + WS_KMEAN); float* ssq = (float*)(ws + WS_SSQ);
    bf16* wts = (bf16*)(ws + WS_W); bf16* hb = (bf16*)(ws + WS_HB); bf16* act = (bf16*)(ws + WS_ACT); bf16* qo = (bf16*)(ws + WS_ACT); bf16* ob = (bf16*)(ws + WS_ACT + 64 * MiB);
    bf16* kb = (bf16*)(ws + WS_K); bf16* vb = (bf16*)(ws + WS_V);
    float* out = args.out;
    const int lo = args.ph_lo, hi_ph = args.ph_hi;
    cg::grid_group grid = cg::this_grid();
#define IN(k) (lo <= (k) && (k) < hi_ph)
#define SEAM0(k) do { if (IN(k) && IN((k) + 1)) { asm volatile("s_waitcnt vmcnt(0)" ::: "memory"); __builtin_amdgcn_fence(__ATOMIC_RELEASE, "workgroup"); grid.sync(); } } while (0)
#define SEAM(k) do { if (IN(k) && IN((k) + 1)) xcd_barrier(bar); } while (0)
    static_assert(MC_END <= 147440, "MoBA LDS map below the barrier's set-up words");
    volatile LAS unsigned* bst = (volatile LAS unsigned*)(lds + 147440);
    if (tid < 2) bst[tid] = 0u;
    __syncthreads();
    unsigned* barw = (unsigned*)ws;
    XcdBarrier bar; bar.bar = barw; bar.x = 0u; bar.st = bst;

    if (IN(0)) {
        LAS float* scr = (LAS float*)(lds + wave * 16384);
        const int gw = vcu * NWAVES + wave, NGW = G * NWAVES;
        constexpr int I_F = 1408;
        constexpr int I_FFN = 12 * I_F, I_QKV = 16 * 96, I_SQ = 16 * 32, I_KV = 16 * 64, NITEMS = I_FFN + I_QKV + I_SQ + I_KV + I_SQ + I_SQ;
        for (int it = gw; it < NITEMS; it += NGW) {
            int r = it;
            if (r < I_FFN) {
                const int mi = r / I_F, item = r % I_F, L = mi / 6, which = (mi % 6) / 3, kind = mi % 3;
                bf16* base = wts + WO_FFN + (size_t)(L * 2 + which) * W_FFN;
                if (kind < 2) {
                    const float* W = (which ? (kind ? args.in[IN_F2U] : args.in[IN_F2G]) : (kind ? args.in[IN_F1U] : args.in[IN_F1G])) + (size_t)L * DM * FF;
                    const float* gn = (which ? args.in[IN_F2N] : args.in[IN_F1N]) + L * DM;
                    const int kbi = item / 88, nbi = item % 88, n0 = 32 * nbi;
                    transpose_item(W, gn, DM, FF, base, 64 * kbi, n0, 256 * (n0 >> 7) + (n0 & 127) + 128 * kind, scr, lane);
                } else {
                    const float* W = (which ? args.in[IN_F2D] : args.in[IN_F1D]) + (size_t)L * FF * DM;
                    const int kbi = item / 32, nbi = item % 32;
                    transpose_item(W, nullptr, FF, DM, base + W_GU, 64 * kbi, 32 * nbi, 32 * nbi, scr, lane);
                }
                continue;
            }
            r -= I_FFN;
            if (r < I_QKV) { transpose_item(args.in[IN_AQKV], args.in[IN_MIXN], DM, 3 * DM, wts + WO_QKV, 64 * (r / 96), 32 * (r % 96), 32 * (r % 96), scr, lane); continue; } r -= I_QKV;
            if (r < I_SQ) { transpose_item(args.in[IN_AO], nullptr, DM, DM, wts + WO_AO, 64 * (r / 32), 32 * (r % 32), 32 * (r % 32), scr, lane); continue; } r -= I_SQ;
            if (r < I_KV) { transpose_item(args.in[IN_KVW], args.in[IN_KVN], DM, 2 * DM, wts + WO_KV, 64 * (r / 64), 32 * (r % 64), 32 * (r % 64), scr, lane); continue; } r -= I_KV;
            if (r < I_SQ) { transpose_item(args.in[IN_BQ], args.in[IN_MIXN] + DM, DM, DM, wts + WO_BQ, 64 * (r / 32), 32 * (r % 32), 32 * (r % 32), scr, lane); continue; } r -= I_SQ;
            transpose_item(args.in[IN_BO], nullptr, DM, DM, wts + WO_BO, 64 * (r / 32), 32 * (r % 32), 32 * (r % 32), scr, lane);
        }
        const float* x = args.in[IN_X];
        for (int mb = gw; mb < MROWS; mb += 4 * NGW) {
            f32x4 v[4][4];
#pragma unroll
            for (int r = 0; r < 4; ++r) { const int m = mb + r * NGW; if (m < MROWS) { const f32x4* xr = (const f32x4*)(x + (size_t)m * DM) + lane;
#pragma unroll
                for (int j = 0; j < 4; ++j) v[r][j] = xr[64 * j]; } }
#pragma unroll
            for (int r = 0; r < 4; ++r) { const int m = mb + r * NGW; if (m < MROWS) {
                float s = 0.f;
#pragma unroll
                for (int j = 0; j < 4; ++j) s += (v[r][j][0] * v[r][j][0] + v[r][j][1] * v[r][j][1]) + (v[r][j][2] * v[r][j][2] + v[r][j][3] * v[r][j][3]);
                s = wave_sum(s);
                u32x2* o8 = (u32x2*)(hb + (size_t)m * DM) + lane;
#pragma unroll
                for (int j = 0; j < 4; ++j) { u32x2 w; w.x = cvtpk(v[r][j][0], v[r][j][1]); w.y = cvtpk(v[r][j][2], v[r][j][3]); o8[64 * j] = w; }
                if (lane < 16) ssq[(size_t)m * 16 + lane] = lane == 0 ? s : 0.f; } }
        }
        if (bx == 0) for (int i = tid; i < XCD_BAR_WORDS; i += NWAVES * 64) barw[i] = 0u;
        for (int idx = bx * (NWAVES * 64) + tid; idx < SEQ * 8; idx += G * NWAVES * 64) {
            const int pos = idx >> 3, i = idx & 7;
            const float inv_freq = i == 0 ? 1.0f : i == 1 ? 0.19392274474868576f : i == 2 ? 0.03760603093086393f : i == 3 ? 0.007292664737217109f : i == 4 ? 0.001414213562373095f
                                 : i == 5 ? 0.0002742481756762073f : i == 6 ? 5.318295896944988e-05f : 1.031338537721246e-05f;
            const float ang = (float)pos * inv_freq;
            const double qd = __builtin_rint((double)ang * 0.6366197723675814);
            const double y = __builtin_fma(-qd, 1.5707963267948966, (double)ang) - qd * 6.123233995736766e-17, y2 = y * y;
            const double sy = y * (1.0 + y2 * (-1.0 / 6 + y2 * (1.0 / 120 + y2 * (-1.0 / 5040 + y2 * (1.0 / 362880 + y2 * (-1.0 / 39916800 + y2 * (1.0 / 6227020800.0)))))));
            const double cy = 1.0 + y2 * (-0.5 + y2 * (1.0 / 24 + y2 * (-1.0 / 720 + y2 * (1.0 / 40320 + y2 * (-1.0 / 3628800 + y2 * (1.0 / 479001600 + y2 * (-1.0 / 87178291200.0)))))));
            const int qm = ((int)qd) & 3;
            const double cv = qm == 0 ? cy : qm == 1 ? -sy : qm == 2 ? -cy : sy, sv = qm == 0 ? sy : qm == 1 ? cy : qm == 2 ? -sy : -cy;
            rope[pos * 16 + i] = (float)cv; rope[pos * 16 + 8 + i] = (float)sv;
        }
    }
    SEAM0(0);
    if (IN(0) && IN(1)) bar = xcd_barrier_post(barw, bst);

#define GEMM_GU(L, which) do { pg8::Gemm g{hb, wts + WO_FFN + (size_t)((L) * 2 + (which)) * W_FFN, MROWS, 2 * FF, DM}; pg8::StaticOrder S; S.init(MROWS, 2 * FF, G, bx); \
        pg8::EpiSwiGLU E{act, ssq, FF}; pg8::gemm_phase<pg8::EpiSwiGLU, pg8::StaticOrder, true, true>(lds, g, S, E); } while (0)
#define GEMM_DOWN(L, which, basep, hbp) do { pg8::Gemm g{act, wts + WO_FFN + (size_t)((L) * 2 + (which)) * W_FFN + W_GU, MROWS, DM, FF}; pg8::StaticOrder S; S.init(MROWS, DM, G, bx); \
        pg8::EpiResid E{hb, ssq, 0.5f}; pg8::gemm_phase<pg8::EpiResid, pg8::StaticOrder, true, true>(lds, g, S, E); } while (0)
#define GEMM_WO(woff) do { pg8::Gemm g{ob, wts + (woff), MROWS, DM, DM}; pg8::StaticOrder S; S.init(MROWS, DM, G, bx); \
        pg8::EpiResid E{hb, ssq, 1.0f}; pg8::gemm_phase<pg8::EpiResid, pg8::StaticOrder, true, true>(lds, g, S, E); } while (0)

    if (IN(1)) for (int rep = 0; rep < REP_P1; ++rep) GEMM_GU(0, 0);
    SEAM(1);
    if (IN(2)) for (int rep = 0; rep < REP_P2; ++rep) GEMM_DOWN(0, 0, args.in[IN_X], hb);
    SEAM(2);
    if (IN(3)) for (int rep = 0; rep < REP_P3; ++rep) { pg8::Gemm g{hb, wts + WO_QKV, MROWS, 3 * DM, DM}; pg8::StaticOrder S; S.init(MROWS, 3 * DM, G, bx);
        pg8::EpiProj E{qo, (size_t)(WS_K - WS_ACT) / 2, (size_t)(WS_V - WS_K) / 2, 3u, 0u, ssq, rope, nullptr, C2}; pg8::gemm_phase<pg8::EpiProj, pg8::StaticOrder, true, true>(lds, g, S, E); }
    SEAM(3);
    if (IN(4)) for (int rep = 0; rep < REP_P4; ++rep) dilated_phase(lds, qo, kb, vb, ob, vcu, G);
    SEAM(4);
    if (IN(5)) GEMM_WO(WO_AO);
    SEAM(5);
    if (IN(6)) GEMM_GU(0, 1);
    SEAM(6);
    if (IN(7)) GEMM_DOWN(0, 1, out, hb);
    SEAM(7);
    if (IN(8)) {
        { pg8::Gemm g{hb, wts + WO_KV, MROWS, 2 * DM, DM}; pg8::StaticOrder S; S.init(MROWS, 2 * DM, G, bx);
          pg8::EpiProj E{kb, (size_t)(WS_V - WS_K) / 2, 0, 1u, 0u, ssq, rope, kmp, 1.0f}; pg8::gemm_phase<pg8::EpiProj, pg8::StaticOrder, true, true>(lds, g, S, E); }
        GEMM_GU(1, 0);
    }
    SEAM(8);
    if (IN(9)) GEMM_DOWN(1, 0, out, hb);
    SEAM(9);
    if (IN(10)) {
        for (int idx = bx * (NWAVES * 64) + tid; idx < 128 * DM; idx += G * NWAVES * 64) { const int blk = idx >> 10, col = idx & 1023;
            kmean[idx] = (kmp[(size_t)(blk * 2) * DM + col] + kmp[(size_t)(blk * 2 + 1) * DM + col]) * (1.0f / 256.0f); }
        pg8::Gemm g{hb, wts + WO_BQ, MROWS, DM, DM}; pg8::StaticOrder S; S.init(MROWS, DM, G, bx);
        pg8::EpiProj E{qo, 0, 0, 1u, 0u, ssq, rope, nullptr, C2}; pg8::gemm_phase<pg8::EpiProj, pg8::StaticOrder, true, true>(lds, g, S, E);
    }
    SEAM(10);
    if (IN(11)) for (int rep = 0; rep < REP_P11; ++rep) moba_phase(lds, qo, kb, vb, kmean, ob, (float*)(ws + WS_MP) + (size_t)bx * (256 * 3 * 64), (float*)(ws + WS_ML) + (size_t)bx * 768, (float*)(ws + WS_MM) + (size_t)bx * 768, vcu, G);
    SEAM(11);
    if (IN(12)) GEMM_WO(WO_BO);
    SEAM(12);
    if (IN(13)) GEMM_GU(1, 1);
    SEAM(13);
    if (IN(14)) GEMM_DOWN(1, 1, out, (bf16*)nullptr);
    SEAM(14);
    if (IN(15)) {
        const int gw = vcu * NWAVES + wave, NGW = G * NWAVES;
        const float* gfin = args.in[IN_FINN];
        f32x4 gv[4];
#pragma unroll
        for (int j = 0; j < 4; ++j) gv[j] = *(const f32x4*)(gfin + (j >> 1) * 512 + 8 * lane + 4 * (j & 1));
        for (int mb = gw; mb < MROWS; mb += 4 * NGW) {
            u32x4 v[4][2]; float rs[4];
#pragma unroll
            for (int r = 0; r < 4; ++r) { const int m = mb + r * NGW; if (m < MROWS) { rs[r] = pg8::row_rs(ssq, m);
                v[r][0] = *(const u32x4*)(hb + (size_t)m * DM + 8 * lane); v[r][1] = *(const u32x4*)(hb + (size_t)m * DM + 512 + 8 * lane); } }
#pragma unroll
            for (int r = 0; r < 4; ++r) { const int m = mb + r * NGW; if (m < MROWS) {
#pragma unroll
                for (int hf = 0; hf < 2; ++hf) { const u32x4 p = v[r][hf];
                    const f32x4 a0 = {__uint_as_float(p.x << 16), __uint_as_float(p.x & 0xffff0000u), __uint_as_float(p.y << 16), __uint_as_float(p.y & 0xffff0000u)};
                    const f32x4 a1 = {__uint_as_float(p.z << 16), __uint_as_float(p.z & 0xffff0000u), __uint_as_float(p.w << 16), __uint_as_float(p.w & 0xffff0000u)};
                    float* o = out + (size_t)m * DM + hf * 512 + 8 * lane;
                    *(f32x4*)o = a0 * rs[r] * gv[2 * hf]; *(f32x4*)(o + 4) = a1 * rs[r] * gv[2 * hf + 1]; } } }
        }
    }
#undef IN
#undef SEAM
#undef SEAM0
}

#ifndef MK_ONE_LAUNCH
#define MK_ONE_LAUNCH 1
#endif
extern "C" void kernel_launch(void* const* d_in, const int* in_sizes, int n_in, void* d_out, int out_size, void* d_ws, size_t ws_size, hipStream_t stream) {
    static int grid = 0;
    if (grid == 0) {
        if (n_in != 17 || in_sizes[0] != MROWS * DM || out_size != MROWS * DM || ws_size < WS_END) {
            fprintf(stderr, "kernel_launch: unexpected shapes (n_in %d, in0 %d, out %d, ws %zu)\n", n_in, n_in > 0 ? in_sizes[0] : -1, out_size, ws_size); grid = -1; return; }
        int dev = 0, cus = 0, per_cu = 0;
        (void)hipGetDevice(&dev); (void)hipDeviceGetAttribute(&cus, hipDeviceAttributeMultiprocessorCount, dev);
        if (hipFuncSetAttribute((const void*)fwd_kernel, hipFuncAttributeMaxDynamicSharedMemorySize, LDS_BYTES) != hipSuccess) { fprintf(stderr, "kernel_launch: hipFuncSetAttribute failed\n"); grid = -1; return; }
        if (hipOccupancyMaxActiveBlocksPerMultiprocessor(&per_cu, (const void*)fwd_kernel, NWAVES * 64, LDS_BYTES) != hipSuccess || per_cu < 1) { fprintf(stderr, "kernel_launch: occupancy query gives %d\n", per_cu); per_cu = 1; }
        (void)hipGetLastError();
        grid = cus * per_cu;
        if (grid % 8 != 0 || grid <= 0) { fprintf(stderr, "kernel_launch: grid %d not a multiple of 8\n", grid); }
    }
    if (grid < 0) return;
    Args a{};
    for (int i = 0; i < 17; ++i) a.in[i] = (const float*)d_in[i];
    a.out = (float*)d_out; a.ws = (unsigned char*)d_ws;
#if MK_ONE_LAUNCH
    a.ph_lo = 0; a.ph_hi = N_PHASES;
    void* kargs[] = {&a};
    hipError_t e = hipLaunchCooperativeKernel((const void*)fwd_kernel, dim3(grid), dim3(NWAVES * 64), kargs, LDS_BYTES, stream);
    if (e != hipSuccess) fprintf(stderr, "kernel_launch: cooperative launch failed: %s (grid %d)\n", hipGetErrorString(e), grid);
#else
    for (int ph = 0; ph < N_PHASES; ++ph) {
        a.ph_lo = ph; a.ph_hi = ph + 1;
        hipLaunchKernelGGL(fwd_kernel, dim3(grid), dim3(NWAVES * 64), LDS_BYTES, stream, a);
    }
#endif
}
#undef sb0
#undef sb1
#undef sb2
```

```cpp
#include <hip/hip_runtime.h>
#include <hip/hip_cooperative_groups.h>
#include <cstdio>
#include <cstdint>
#include <cmath>
namespace cg = cooperative_groups;
namespace pg8 {
#define PG8_LAS __attribute__((address_space(3)))
typedef unsigned short bf16_t;
typedef short bf16x8 __attribute__((ext_vector_type(8)));
typedef float f32x4 __attribute__((ext_vector_type(4)));
typedef unsigned u32x4 __attribute__((ext_vector_type(4)));
constexpr int BM = 256, BK = 64, HALF = 128, HTB = HALF * BK * 2  , STAGE_BYTES = 8 * HTB, NXCD = 8, WGM = 8;

__host__ __device__ __forceinline__ int lds_byte(int r, int c) { const int st = (r >> 4) * 2 + (c >> 5), rr = r & 15, cc = c & 31, ob = rr * 64 + cc * 2; return st * 1024 + (ob ^ (((ob >> 9) & 1) << 5)); }
__host__ __device__ __forceinline__ void stage_rc(int b, int& R, int& C) { const int st = b / 1024, sb = b % 1024, swz = sb ^ (((sb >> 9) & 1) << 5); R = (st >> 1) * 16 + swz / 64; C = (st & 1) * 32 + (swz % 64) / 2; }
__host__ __device__ __forceinline__ int perm32(int rho) { const int n = rho >> 4, i = rho & 15; return 8 * (i >> 2) + 4 * n + (i & 3); }

struct Unit { int pm, pn; };
struct Gemm { const bf16_t* A; const bf16_t* Bt; int M, N, K; };

struct StaticOrder {
    int nM, nN, nwg, G, c;
    __host__ __device__ void init(int M, int N, int G_, int c_) { nM = M / BM; nN = N / BM; nwg = nM * nN; G = G_; c = c_; }
    __host__ __device__ bool next(int i, Unit& u) const {
        const long L = (long)i * G + c; if (L >= nwg) return false;
        int wgid = (int)L; { const int q = nwg / NXCD, r = nwg % NXCD, xcd = wgid % NXCD, off = wgid / NXCD; wgid = (xcd < r ? xcd * (q + 1) : r * (q + 1) + (xcd - r) * q) + off; }
        const int nig = WGM * nN, gid = wgid / nig, fm = gid * WGM, gsz = (nM - fm) < WGM ? (nM - fm) : WGM;
        u.pm = fm + ((wgid % nig) % gsz); u.pn = (wgid % nig) / gsz; return true;
    }
    __device__ __forceinline__ void a_ready(const Unit&) const {}
    __device__ __forceinline__ void done(const Unit&) const {}
};
__device__ __forceinline__ unsigned cvt_pk_bf16(float lo, float hi) { unsigned r; asm volatile("v_cvt_pk_bf16_f32 %0, %1, %2" : "=v"(r) : "v"(lo), "v"(hi)); return r; }
typedef float f32x2 __attribute__((ext_vector_type(2)));
typedef unsigned u32x4e __attribute__((ext_vector_type(4)));
__device__ __forceinline__ float row_rs(const float* ssq, int row) {
    const f32x4* p = (const f32x4*)(ssq + (size_t)row * 16);
    const f32x4 a = p[0], b = p[1], c = p[2], d = p[3];
    const float s = (((a[0] + a[1]) + (a[2] + a[3])) + ((b[0] + b[1]) + (b[2] + b[3]))) + (((c[0] + c[1]) + (c[2] + c[3])) + ((d[0] + d[1]) + (d[2] + d[3])));
    return __builtin_amdgcn_rsqf(s * (1.0f / 1024.0f) + 1e-6f);
}
template <int NR> __device__ __forceinline__ void row_rsn(const float* ssq, int row0, int fq, float (&rs)[NR]) {
    f32x4 p[NR];
#pragma unroll
    for (int m = 0; m < NR; ++m) p[m] = *(const f32x4*)(ssq + (size_t)(row0 + 16 * m) * 16 + 4 * fq);
#pragma unroll
    for (int m = 0; m < NR; ++m) {
        float s = (p[m][0] + p[m][1]) + (p[m][2] + p[m][3]);
        s += __shfl_xor(s, 16); s += __shfl_xor(s, 32);
        rs[m] = __builtin_amdgcn_rsqf(s * (1.0f / 1024.0f) + 1e-6f);
    }
}
__device__ __forceinline__ float swiglu1(float g, float u) { return g * u * __builtin_amdgcn_rcpf(1.0f + __builtin_amdgcn_exp2f(g * -1.4426950408889634f)); }
struct EpiSwiGLU {
    static constexpr bool PERM = true, AFTER_DRAIN = false;
    bf16_t* O; const float* ssq; int ldo;
    __device__ __forceinline__ void operator()(const f32x4 (&acc)[2][2][4][2], const Unit& u, int wr, int wc, int fr, int fq) const {
        const int col0 = u.pn * 128 + wc * 32 + 8 * fq;
#pragma unroll
        for (int ai = 0; ai < 2; ++ai) {
            float rsv[4]; row_rsn<4>(ssq, u.pm * BM + ai * HALF + wr * 64 + fr, fq, rsv);
#pragma unroll
            for (int m = 0; m < 4; ++m) {
                const int row = u.pm * BM + ai * HALF + wr * 64 + m * 16 + fr;
                const float rs = rsv[m];
                const f32x4 g0 = acc[ai][0][m][0] * rs, g1 = acc[ai][0][m][1] * rs, u0 = acc[ai][1][m][0] * rs, u1 = acc[ai][1][m][1] * rs;
                u32x4e w;
                w.x = cvt_pk_bf16(swiglu1(g0[0], u0[0]), swiglu1(g0[1], u0[1])); w.y = cvt_pk_bf16(swiglu1(g0[2], u0[2]), swiglu1(g0[3], u0[3]));
                w.z = cvt_pk_bf16(swiglu1(g1[0], u1[0]), swiglu1(g1[1], u1[1])); w.w = cvt_pk_bf16(swiglu1(g1[2], u1[2]), swiglu1(g1[3], u1[3]));
                *(u32x4e*)(O + (size_t)row * ldo + col0) = w;
            }
        }
    }
};
struct EpiResid {
    static constexpr bool PERM = true, AFTER_DRAIN = false;
    bf16_t* hb; float* ssq; float alpha;
    __device__ __forceinline__ void operator()(const f32x4 (&acc)[2][2][4][2], const Unit& u, int wr, int wc, int fr, int fq) const {
        const int col0 = u.pn * BM + wc * 32 + 8 * fq;
#pragma unroll
        for (int ai = 0; ai < 2; ++ai) {
            u32x4e pre[4][2];
#pragma unroll
            for (int m = 0; m < 4; ++m)
#pragma unroll
                for (int bj = 0; bj < 2; ++bj) pre[m][bj] = *(const u32x4e*)(hb + (size_t)(u.pm * BM + ai * HALF + wr * 64 + m * 16 + fr) * 1024 + col0 + bj * HALF);
#pragma unroll
            for (int m = 0; m < 4; ++m) {
                const int row = u.pm * BM + ai * HALF + wr * 64 + m * 16 + fr;
                float s = 0.f;
#pragma unroll
                for (int bj = 0; bj < 2; ++bj) {
                    const size_t off = (size_t)row * 1024 + col0 + bj * HALF;
                    const u32x4e p = pre[m][bj];
                    const f32x4 r0 = {__uint_as_float(p.x << 16), __uint_as_float(p.x & 0xffff0000u), __uint_as_float(p.y << 16), __uint_as_float(p.y & 0xffff0000u)};
                    const f32x4 r1 = {__uint_as_float(p.z << 16), __uint_as_float(p.z & 0xffff0000u), __uint_as_float(p.w << 16), __uint_as_float(p.w & 0xffff0000u)};
                    const f32x4 v0 = r0 + acc[ai][bj][m][0] * alpha, v1 = r1 + acc[ai][bj][m][1] * alpha;
                    u32x4e w; w.x = cvt_pk_bf16(v0[0], v0[1]); w.y = cvt_pk_bf16(v0[2], v0[3]); w.z = cvt_pk_bf16(v1[0], v1[1]); w.w = cvt_pk_bf16(v1[2], v1[3]); *(u32x4e*)(hb + off) = w;
                    s += ((v0[0] * v0[0] + v0[1] * v0[1]) + (v0[2] * v0[2] + v0[3] * v0[3])) + ((v1[0] * v1[0] + v1[1] * v1[1]) + (v1[2] * v1[2] + v1[3] * v1[3]));
                }
                s += __shfl_xor(s, 16); s += __shfl_xor(s, 32);
                if (fq == 0) ssq[(size_t)row * 16 + u.pn * 4 + wc] = s;
            }
        }
    }
};
struct EpiProj {
    static constexpr bool PERM = true, AFTER_DRAIN = false;
    bf16_t* O0; size_t off1, off2; unsigned rot_mask, swz_mask; const float* ssq; const float* rope; float* kmp; float scale0;
    __device__ __forceinline__ void operator()(const f32x4 (&acc)[2][2][4][2], const Unit& u, int wr, int wc, int fr, int fq) const {
        const int sec = u.pn >> 2;
        size_t so = 0; if (sec >= 1) so += off1; if (sec >= 2) so += off2;
        bf16_t* dst = O0 + so;
        const bool rot = (((rot_mask >> sec) & 1u) != 0u) && ((wc & 1) == 0);
        const bool km = (kmp != nullptr) && (sec == 0);
        const bool swz = ((swz_mask >> sec) & 1u) != 0u;
        const int colS = (u.pn & 3) * BM + wc * 32 + 8 * fq;
        f32x4 ks[2][2];
#pragma unroll
        for (int bj = 0; bj < 2; ++bj)
#pragma unroll
            for (int n = 0; n < 2; ++n) ks[bj][n] = (f32x4){0.f, 0.f, 0.f, 0.f};
        const float sc = sec == 0 ? scale0 : 1.0f;
#pragma unroll
        for (int ai = 0; ai < 2; ++ai)
#pragma unroll
        for (int mp = 0; mp < 2; ++mp) {
            float rsv[2]; row_rsn<2>(ssq, u.pm * BM + ai * HALF + wr * 64 + mp * 32 + fr, fq, rsv);
            f32x4 rp4[2][4];
            if (rot) {
#pragma unroll
                for (int m2 = 0; m2 < 2; ++m2) { const f32x4* rp = (const f32x4*)(rope + (size_t)((u.pm * BM + ai * HALF + wr * 64 + (mp * 2 + m2) * 16 + fr) & 4095) * 16);
                    rp4[m2][0] = rp[0]; rp4[m2][1] = rp[1]; rp4[m2][2] = rp[2]; rp4[m2][3] = rp[3]; }
            }
#pragma unroll
            for (int m2 = 0; m2 < 2; ++m2) {
                const int m = mp * 2 + m2;
                const int row = u.pm * BM + ai * HALF + wr * 64 + m * 16 + fr;
                const float rs = rsv[m2] * sc;
                f32x4 cs[2], sn[2];
                if (rot) { cs[0] = rp4[m2][0]; cs[1] = rp4[m2][1]; sn[0] = rp4[m2][2]; sn[1] = rp4[m2][3]; }
#pragma unroll
                for (int bj = 0; bj < 2; ++bj) {
                    f32x4 v[2];
#pragma unroll
                    for (int n = 0; n < 2; ++n) {
                        v[n] = acc[ai][bj][m][n] * rs;
                        if (rot) {
                            f32x4 o;
#pragma unroll
                            for (int e = 0; e < 4; ++e) o[e] = __shfl_xor(v[n][e], 16);
                            if (fq == 0) v[n] = v[n] * cs[n] - o * sn[n];
                            else if (fq == 1) v[n] = o * sn[n] + v[n] * cs[n];
                        }
                        if (km) ks[bj][n] += v[n];
                    }
                    u32x4e w; w.x = cvt_pk_bf16(v[0][0], v[0][1]); w.y = cvt_pk_bf16(v[0][2], v[0][3]); w.z = cvt_pk_bf16(v[1][0], v[1][1]); w.w = cvt_pk_bf16(v[1][2], v[1][3]);
                    int col = colS + bj * HALF;
                    if (swz) { const int pp = row & 4095; col = ((((col >> 6) + pp) & 15) << 6) | (col & 63); }
                    *(u32x4e*)(dst + (size_t)row * 1024 + col) = w;
                }
            }
        }
        if (km) {
#pragma unroll
            for (int bj = 0; bj < 2; ++bj)
#pragma unroll
                for (int n = 0; n < 2; ++n) {
                    f32x4 t = ks[bj][n];
#pragma unroll
                    for (int e = 0; e < 4; ++e) { float x = t[e]; x += __shfl_xor(x, 1); x += __shfl_xor(x, 2); x += __shfl_xor(x, 4); x += __shfl_xor(x, 8); t[e] = x; }
                    if (fr == 0) *(f32x4*)(kmp + (size_t)(u.pm * 2 + wr) * 1024 + colS + bj * HALF + 4 * n) = t;
                }
        }
    }
};

template <class Epi, class Sched, bool ALIGN_EPI = false, bool SP2 = false>
__device__ __forceinline__ void gemm_phase(PG8_LAS unsigned char* lds, const Gemm g, const Sched& S, const Epi& E) {
    const int tid = threadIdx.x, wid = __builtin_amdgcn_readfirstlane(tid >> 6), lane = tid & 63, wr = wid >> 2, wc = wid & 3, fr = lane & 15, fq = lane >> 4;
    const int K = g.K, nt = K / BK;
    unsigned voffA[2], voffB[2];
#pragma unroll
    for (int i = 0; i < 2; ++i) { int R, C; stage_rc(tid * 16 + i * 8192, R, C); const int Rb = Epi::PERM ? ((R & ~31) + perm32(R & 31)) : R;
        voffA[i] = (unsigned)(R * K + C) * 2u; voffB[i] = (unsigned)(Rb * K + C) * 2u; }
    const size_t kstep = (size_t)(BK * 2);
    const size_t hstep = (size_t)HALF * K * 2;
    const size_t tstep = 2 * hstep;
    const unsigned ldsw = (unsigned)wid * 1024u;
    const int aoff = lds_byte(wr * 64 + fr, fq * 8), boff = lds_byte(wc * 32 + fr, fq * 8);
#define PG8_SA(b, h) (((b) * 2 + (h)) * HTB)
#define PG8_SB(b, h) ((4 + (b) * 2 + (h)) * HTB)
#define PG8_STAGE(bufoff, gbase, voff) do { _Pragma("unroll") for (int _i = 0; _i < 2; ++_i) \
        __builtin_amdgcn_global_load_lds((const unsigned*)((const char*)(gbase) + (voff)[_i]), (PG8_LAS unsigned*)(lds + (bufoff) + ldsw + _i * 8192), 16, 0, 0); } while (0)
#define PG8_LDA(dst, b, h) do { _Pragma("unroll") for (int m = 0; m < 4; ++m) _Pragma("unroll") for (int k = 0; k < 2; ++k) dst[m][k] = *(const PG8_LAS bf16x8*)(lds + PG8_SA(b, h) + aoff + m * 2048 + k * 1024); } while (0)
#define PG8_LDB(dst, b, h) do { _Pragma("unroll") for (int n = 0; n < 2; ++n) _Pragma("unroll") for (int k = 0; k < 2; ++k) dst[n][k] = *(const PG8_LAS bf16x8*)(lds + PG8_SB(b, h) + boff + n * 2048 + k * 1024); } while (0)
#define PG8_MMA(ai, bj, At, Bt) do { __builtin_amdgcn_s_setprio(1); _Pragma("unroll") for (int m = 0; m < 4; ++m) _Pragma("unroll") for (int n = 0; n < 2; ++n) _Pragma("unroll") for (int k = 0; k < 2; ++k) \
        acc[ai][bj][m][n] = __builtin_amdgcn_mfma_f32_16x16x32_bf16(Bt[n][k], At[m][k], acc[ai][bj][m][n], 0, 0, 0); __builtin_amdgcn_s_setprio(0); } while (0)
#define PG8_WAIT_V(n) asm volatile("s_waitcnt vmcnt(" #n ")" ::: "memory")
#define PG8_WAIT_L(n) asm volatile("s_waitcnt lgkmcnt(" #n ")" ::: "memory")
#define PG8_BAR __builtin_amdgcn_s_barrier()
#define PG8_SCHED __builtin_amdgcn_sched_barrier(0)
    Unit cur, nxt; int ui = 0;
    if (!S.next(0, cur)) return;
    f32x4 acc[2][2][4][2];
#pragma unroll
    for (int a = 0; a < 2; ++a)
#pragma unroll
        for (int b = 0; b < 2; ++b)
#pragma unroll
            for (int m = 0; m < 4; ++m)
#pragma unroll
                for (int n = 0; n < 2; ++n) acc[a][b][m][n] = (f32x4){0.f, 0.f, 0.f, 0.f};
    bf16x8 At[4][2], B0[2][2], B1[2][2];
    const char* cA = (const char*)g.A + (size_t)cur.pm * tstep; const char* cB = (const char*)g.Bt + (size_t)cur.pn * tstep;
    S.a_ready(cur);
    if constexpr (SP2) {
        PG8_STAGE(PG8_SB(0, 0), cB, voffB); PG8_STAGE(PG8_SB(0, 1), cB + hstep, voffB); PG8_STAGE(PG8_SA(0, 0), cA, voffA); PG8_STAGE(PG8_SA(0, 1), cA + hstep, voffA);
        if (wr == 1) PG8_BAR;
        PG8_WAIT_V(2); PG8_BAR;
        PG8_STAGE(PG8_SB(1, 0), cB + kstep, voffB); PG8_STAGE(PG8_SA(1, 0), cA + kstep, voffA); PG8_STAGE(PG8_SB(1, 1), cB + hstep + kstep, voffB);
        PG8_WAIT_V(6); PG8_BAR;
    } else {
        PG8_STAGE(PG8_SB(0, 0), cB, voffB); PG8_STAGE(PG8_SA(0, 0), cA, voffA); PG8_STAGE(PG8_SB(0, 1), cB + hstep, voffB); PG8_STAGE(PG8_SA(0, 1), cA + hstep, voffA);
        if (wr == 1) PG8_BAR;
        PG8_WAIT_V(4); PG8_BAR;
        PG8_STAGE(PG8_SB(1, 0), cB + kstep, voffB); PG8_STAGE(PG8_SA(1, 0), cA + kstep, voffA); PG8_STAGE(PG8_SB(1, 1), cB + hstep + kstep, voffB);
        PG8_WAIT_V(6); PG8_BAR;
    }
    for (;;) {
        const bool has_next = S.next(ui + 1, nxt);
        const char* nA = has_next ? (const char*)g.A + (size_t)nxt.pm * tstep : cA; const char* nB = has_next ? (const char*)g.Bt + (size_t)nxt.pn * tstep : cB;
        for (int t = 0; t < nt; t += 2) {
            const bool last = (t == nt - 2);
            const char* a1 = cA + (size_t)(t + 1) * kstep;
            const char* a2 = last ? nA : cA + (size_t)(t + 2) * kstep; const char* b2 = last ? nB : cB + (size_t)(t + 2) * kstep;
            const char* a3 = a2 + kstep; const char* b3 = b2 + kstep;
            if (last && has_next) S.a_ready(nxt);
            if constexpr (SP2) {
            PG8_LDB(B0, 0, 0); PG8_LDB(B1, 0, 1); PG8_SCHED; PG8_LDA(At, 0, 0); PG8_STAGE(PG8_SA(1, 1), a1 + hstep, voffA);
            PG8_WAIT_V(8); PG8_WAIT_L(0); PG8_BAR; PG8_MMA(0, 0, At, B0); PG8_MMA(0, 1, At, B1); PG8_BAR; PG8_SCHED;
            PG8_LDA(At, 0, 1); PG8_STAGE(PG8_SB(0, 0), b2, voffB); PG8_STAGE(PG8_SB(0, 1), b2 + hstep, voffB); PG8_STAGE(PG8_SA(0, 0), a2, voffA);
            PG8_WAIT_V(8); PG8_WAIT_L(0); PG8_BAR; PG8_MMA(1, 0, At, B0); PG8_MMA(1, 1, At, B1); PG8_BAR; PG8_SCHED;
            PG8_LDB(B0, 1, 0); PG8_LDB(B1, 1, 1); PG8_SCHED; PG8_LDA(At, 1, 0); PG8_STAGE(PG8_SA(0, 1), a2 + hstep, voffA);
            PG8_WAIT_V(8); PG8_WAIT_L(0); PG8_BAR; PG8_MMA(0, 0, At, B0); PG8_MMA(0, 1, At, B1); PG8_BAR; PG8_SCHED;
            PG8_LDA(At, 1, 1); PG8_STAGE(PG8_SB(1, 0), b3, voffB); PG8_STAGE(PG8_SB(1, 1), b3 + hstep, voffB); PG8_STAGE(PG8_SA(1, 0), a3, voffA);
            PG8_WAIT_V(8); PG8_WAIT_L(0); PG8_BAR; PG8_MMA(1, 0, At, B0); PG8_MMA(1, 1, At, B1); PG8_BAR; PG8_SCHED;
            } else {
            PG8_LDB(B0, 0, 0); PG8_SCHED; PG8_LDA(At, 0, 0); PG8_STAGE(PG8_SA(1, 1), a1 + hstep, voffA);
            PG8_WAIT_L(8); PG8_BAR; PG8_WAIT_L(0); PG8_MMA(0, 0, At, B0); PG8_BAR; PG8_SCHED;
            PG8_LDB(B1, 0, 1); PG8_STAGE(PG8_SB(0, 0), b2, voffB);
            PG8_BAR; PG8_WAIT_L(0); PG8_MMA(0, 1, At, B1); PG8_BAR;
            PG8_LDA(At, 0, 1); PG8_STAGE(PG8_SA(0, 0), a2, voffA);
            PG8_BAR; PG8_WAIT_L(0); PG8_MMA(1, 0, At, B0); PG8_BAR; PG8_SCHED;
            PG8_STAGE(PG8_SB(0, 1), b2 + hstep, voffB);
            PG8_WAIT_V(6); PG8_BAR; PG8_MMA(1, 1, At, B1); PG8_BAR;
            PG8_LDB(B0, 1, 0); PG8_SCHED; PG8_LDA(At, 1, 0); PG8_STAGE(PG8_SA(0, 1), a2 + hstep, voffA);
            PG8_WAIT_L(8); PG8_BAR; PG8_WAIT_L(0); PG8_MMA(0, 0, At, B0); PG8_BAR; PG8_SCHED;
            PG8_LDB(B1, 1, 1); PG8_STAGE(PG8_SB(1, 0), b3, voffB);
            PG8_BAR; PG8_WAIT_L(0); PG8_MMA(0, 1, At, B1); PG8_BAR;
            PG8_LDA(At, 1, 1); PG8_STAGE(PG8_SA(1, 0), a3, voffA);
            PG8_BAR; PG8_WAIT_L(0); PG8_MMA(1, 0, At, B0); PG8_BAR; PG8_SCHED;
            PG8_STAGE(PG8_SB(1, 1), b3 + hstep, voffB);
            PG8_WAIT_V(6); PG8_BAR; PG8_MMA(1, 1, At, B1); PG8_BAR;
            }
        }
        if constexpr (ALIGN_EPI) { if (wr == 0) PG8_BAR; }
        if constexpr (!Epi::AFTER_DRAIN) { E(acc, cur, wr, wc, fr, fq); S.done(cur); }
        if (!has_next) break;
#pragma unroll
        for (int a = 0; a < 2; ++a)
#pragma unroll
            for (int b = 0; b < 2; ++b)
#pragma unroll
                for (int m = 0; m < 4; ++m)
#pragma unroll
                    for (int n = 0; n < 2; ++n) acc[a][b][m][n] = (f32x4){0.f, 0.f, 0.f, 0.f};
        cur = nxt; cA = nA; cB = nB; ++ui;
        if constexpr (ALIGN_EPI) { if (wr == 1) PG8_BAR; }
    }
    PG8_WAIT_V(0);
    if constexpr (!ALIGN_EPI) { if (wr == 0) PG8_BAR; }
    PG8_BAR;
    if constexpr (Epi::AFTER_DRAIN) { E.fused(acc, cur, wr, wc, fr, fq, lds, wid, lane); S.done(cur); }
#undef PG8_SA
#undef PG8_SB
#undef PG8_STAGE
#undef PG8_LDA
#undef PG8_LDB
#undef PG8_MMA
#undef PG8_WAIT_V
#undef PG8_WAIT_L
#undef PG8_BAR
#undef PG8_SCHED
}
}

constexpr int NB = 8, SEQ = 4096, DM = 1024, NH = 16, HD = 64, FF = 2816, MROWS = NB * SEQ;
constexpr int NWAVES = 8;
constexpr size_t MiB = 1u << 20;
constexpr size_t WS_ROPE = 1 * MiB;
constexpr size_t WS_KMP = 2 * MiB;
constexpr size_t WS_KMEAN = 3 * MiB;
constexpr size_t WS_SSQ = 4 * MiB;
constexpr size_t WS_W = 8 * MiB;
constexpr size_t WS_HB = 96 * MiB;
constexpr size_t WS_ACT = 160 * MiB;
constexpr size_t WS_K = 336 * MiB, WS_V = 400 * MiB;
constexpr size_t WS_MP = 464 * MiB;
constexpr size_t WS_ML = 1 * MiB + 256 * 1024;
constexpr size_t WS_MM = 6 * MiB;
constexpr size_t WS_END = 512 * MiB;
constexpr size_t W_GU = (size_t)2 * FF * DM, W_D = (size_t)DM * FF, W_FFN = W_GU + W_D;
constexpr size_t WO_FFN = 0;
constexpr size_t WO_QKV = 4 * W_FFN, WO_AO = WO_QKV + (size_t)3 * DM * DM, WO_KV = WO_AO + (size_t)DM * DM, WO_BQ = WO_KV + (size_t)2 * DM * DM, WO_BO = WO_BQ + (size_t)DM * DM, WO_END = WO_BO + (size_t)DM * DM;
static_assert(WS_W + WO_END * 2 <= WS_HB, "weights fit");
constexpr int LDS_BYTES = 147456;

#define LAS __attribute__((address_space(3)))
typedef unsigned short bf16;
typedef short bf16x8 __attribute__((ext_vector_type(8)));
typedef short s16x4 __attribute__((ext_vector_type(4)));
typedef float f32x4 __attribute__((ext_vector_type(4)));
typedef float f32x16 __attribute__((ext_vector_type(16)));
typedef unsigned u32x4 __attribute__((ext_vector_type(4)));
typedef unsigned u32x2 __attribute__((ext_vector_type(2)));

__device__ __forceinline__ unsigned f2bf(float f) { unsigned u = __builtin_bit_cast(unsigned, f); return (u + 0x7fffu + ((u >> 16) & 1u)) >> 16; }
__device__ __forceinline__ unsigned pk2(float lo, float hi) { return f2bf(lo) | (f2bf(hi) << 16); }
__device__ __forceinline__ unsigned cvtpk(float lo, float hi) { return pg8::cvt_pk_bf16(lo, hi); }

constexpr float C2 = 0.125f * 1.4426950408889634f;
struct AttnState { f32x16 o0, o1; float m, l; };
typedef short v4i16_t __attribute__((ext_vector_type(4)));
__device__ __forceinline__ s16x4 vtr(const LAS char* p) { return __builtin_bit_cast(s16x4, __builtin_amdgcn_ds_read_tr16_b64_v4i16((LAS v4i16_t*)p)); }

__device__ __forceinline__ float xhalf_max(float v) { const auto rr = __builtin_amdgcn_permlane32_swap(__float_as_uint(v), __float_as_uint(v), false, false); return fmaxf(__uint_as_float(rr[0]), __uint_as_float(rr[1])); }
__device__ __forceinline__ float xhalf_sum(float v) { const auto rr = __builtin_amdgcn_permlane32_swap(__float_as_uint(v), __float_as_uint(v), false, false); return __uint_as_float(rr[0]) + __uint_as_float(rr[1]); }
constexpr float ATT_THR = 6.0f;
__device__ __forceinline__ void attn_stage(const u32x4 (&kg)[4], const u32x4 (&vg)[4], LAS char* kw, LAS char* vw) {
#pragma unroll
    for (int j = 0; j < 4; ++j) { *(LAS u32x4*)(kw + j * (8 * 144)) = kg[j]; *(LAS u32x4*)(vw + j * 512) = vg[j]; }
}
template <bool QLDS = false> __device__ __forceinline__ void attn_chunk2(AttnState (&st)[2], const bf16x8 (&qf)[2][4], const int (&D0)[2], const bool (&first)[2], const bool (&act)[2], const bool (&allornone)[2], const LAS char* kr, const LAS char* vr, const LAS char* qr = nullptr) {
    f32x16 s[2];
#pragma unroll
    for (int q = 0; q < 2; ++q) {
        const float negm = -st[q].m;
        if (allornone[q]) {
            const float bq = D0[q] > 0 ? negm : -INFINITY;
#pragma unroll
            for (int r = 0; r < 16; ++r) s[q][r] = bq;
        } else {
#pragma unroll
            for (int r = 0; r < 16; ++r) { const int delta = D0[q] - ((r & 3) + 8 * (r >> 2)); s[q][r] = ((unsigned)delta <= 128u) ? negm : -INFINITY; }
        }
    }
    asm volatile("s_waitcnt lgkmcnt(0)" ::: "memory");
    if (QLDS) {
#pragma unroll
        for (int q = 0; q < 2; ++q) if (act[q]) {
#pragma unroll
            for (int k = 0; k < 4; ++k) { const bf16x8 kv = *(const LAS bf16x8*)(kr + 32 * k), qv = *(const LAS bf16x8*)(qr + q * 4608 + 32 * k);
                s[q] = __builtin_amdgcn_mfma_f32_32x32x16_bf16(kv, qv, s[q], 0, 0, 0); }
        }
    } else {
        bf16x8 kf[4];
#pragma unroll
        for (int k = 0; k < 4; ++k) kf[k] = *(const LAS bf16x8*)(kr + 32 * k);
#pragma unroll
        for (int q = 0; q < 2; ++q) if (act[q]) {
#pragma unroll
            for (int k = 0; k < 4; ++k) s[q] = __builtin_amdgcn_mfma_f32_32x32x16_bf16(kf[k], qf[q][k], s[q], 0, 0, 0);
        }
    }
    s16x4 a[2][2][2];
#define VT(dt, k) (bf16x8){a[dt][k][0][0], a[dt][k][0][1], a[dt][k][0][2], a[dt][k][0][3], a[dt][k][1][0], a[dt][k][1][1], a[dt][k][1][2], a[dt][k][1][3]}
#pragma unroll
    for (int q = 0; q < 2; ++q) {
        bf16x8 pb0 = {}, pb1 = {};
        if (act[q]) {
            float t = fmaxf(fmaxf(s[q][0], s[q][1]), s[q][2]);
#pragma unroll
            for (int r = 3; r < 15; r += 2) t = fmaxf(fmaxf(t, s[q][r]), s[q][r + 1]);
            t = fmaxf(t, s[q][15]);
            t = xhalf_max(t);
            if (first[q] || __builtin_amdgcn_ballot_w64(t > ATT_THR) != 0ull) {
                const float delta = first[q] ? t : fmaxf(t, 0.f);
                st[q].m += delta;
                const float alpha = __builtin_amdgcn_exp2f(-delta);
#pragma unroll
                for (int r = 0; r < 16; ++r) s[q][r] -= delta;
                st[q].l *= alpha; st[q].o0 *= alpha; st[q].o1 *= alpha;
            }
            float ps0 = 0.f, ps1 = 0.f;
#pragma unroll
            for (int r = 0; r < 16; r += 2) { s[q][r] = __builtin_amdgcn_exp2f(s[q][r]); s[q][r + 1] = __builtin_amdgcn_exp2f(s[q][r + 1]); ps0 += s[q][r]; ps1 += s[q][r + 1]; }
            st[q].l += ps0 + ps1;
            u32x4 p0, p1;
            p0.x = cvtpk(s[q][0], s[q][1]); p0.y = cvtpk(s[q][2], s[q][3]); p0.z = cvtpk(s[q][4], s[q][5]); p0.w = cvtpk(s[q][6], s[q][7]);
            p1.x = cvtpk(s[q][8], s[q][9]); p1.y = cvtpk(s[q][10], s[q][11]); p1.z = cvtpk(s[q][12], s[q][13]); p1.w = cvtpk(s[q][14], s[q][15]);
            pb0 = __builtin_bit_cast(bf16x8, p0); pb1 = __builtin_bit_cast(bf16x8, p1);
        }
        if (q == 0) {
#pragma unroll
            for (int dt = 0; dt < 2; ++dt)
#pragma unroll
                for (int k = 0; k < 2; ++k) { a[dt][k][0] = vtr(vr + dt * 2048 + k * 1024); a[dt][k][1] = vtr(vr + dt * 2048 + k * 1024 + 512); }
            asm volatile("s_waitcnt lgkmcnt(0)" ::: "memory");
        }
        if (act[q]) {
            st[q].o0 = __builtin_amdgcn_mfma_f32_32x32x16_bf16(VT(0, 0), pb0, st[q].o0, 0, 0, 0);
            st[q].o1 = __builtin_amdgcn_mfma_f32_32x32x16_bf16(VT(1, 0), pb0, st[q].o1, 0, 0, 0);
            st[q].o0 = __builtin_amdgcn_mfma_f32_32x32x16_bf16(VT(0, 1), pb1, st[q].o0, 0, 0, 0);
            st[q].o1 = __builtin_amdgcn_mfma_f32_32x32x16_bf16(VT(1, 1), pb1, st[q].o1, 0, 0, 0);
        }
    }
#undef VT
}
__device__ __forceinline__ void attn_store(const AttnState& st, bf16* orow, int hi) {
    const float lt = xhalf_sum(st.l);
    const float inv = 1.0f / lt;
#pragma unroll
    for (int g = 0; g < 4; ++g) {
        u32x2 w0, w1;
        w0.x = cvtpk(st.o0[4 * g] * inv, st.o0[4 * g + 1] * inv); w0.y = cvtpk(st.o0[4 * g + 2] * inv, st.o0[4 * g + 3] * inv);
        w1.x = cvtpk(st.o1[4 * g] * inv, st.o1[4 * g + 1] * inv); w1.y = cvtpk(st.o1[4 * g + 2] * inv, st.o1[4 * g + 3] * inv);
        *(u32x2*)(orow + 8 * g + 4 * hi) = w0; *(u32x2*)(orow + 32 + 8 * g + 4 * hi) = w1;
    }
}
__device__ __forceinline__ void attn_load_kv(u32x4 (&kg)[4], u32x4 (&vg)[4], const bf16* K, const bf16* V, size_t rowb, int p0, int pstep, int h, int lane) {
#pragma unroll
    for (int j = 0; j < 4; ++j) { const int pj = p0 + j * pstep; const size_t off = (rowb + pj) * DM + h * HD + 8 * (lane & 7);
        kg[j] = *(const u32x4*)(K + off); vg[j] = *(const u32x4*)(V + off); }
}

__device__ __forceinline__ void dil_desc(int ci, int c, int r16, int n16, int n4, int& d, int& r, int& u0) {
    if (ci < n16) { d = 16; r = r16; u0 = 32 * (c - ci); }
    else if (ci < n16 + n4) { d = 4; r = r16 & 3; u0 = 128 * c + 96 - 32 * (ci - n16); }
    else { d = 1; r = 0; u0 = 512 * c + 480 - 32 * (ci - n16 - n4); }
}
#define ATT_LOOP(NTOT, LOADK, COMPUTE) do { \
    u32x4 kA[4], vA[4]; \
    LOADK(kA, vA, 0); \
    for (int ci = 0; ci < (NTOT); ++ci) { \
        attn_stage(kA, vA, kw, vw); \
        if (ci + 1 < (NTOT)) LOADK(kA, vA, ci + 1); \
        COMPUTE(ci); \
    } } while (0)

__device__ __forceinline__ void dil_desc2(int ci, int c, int r16a, int n16, int n4, int& d, int& r, int& u0, int& who) {
    if (ci < n16) { d = 16; r = r16a; u0 = 32 * (c - ci); who = 0; }
    else if (ci < 2 * n16) { d = 16; r = r16a + 8; u0 = 32 * (c - (ci - n16)); who = 1; }
    else if (ci < 2 * n16 + n4) { d = 4; r = r16a & 3; u0 = 128 * c + 96 - 32 * (ci - 2 * n16); who = 2; }
    else { d = 1; r = 0; u0 = 512 * c + 480 - 32 * (ci - 2 * n16 - n4); who = 2; }
}
__device__ __forceinline__ void dilated_phase(LAS unsigned char* lds, const bf16* Q, const bf16* K, const bf16* V, bf16* O, int vcu, int G) {
    const int tid = threadIdx.x, lane = tid & 63, wid = __builtin_amdgcn_readfirstlane(tid >> 6), hi = lane >> 5, qi = lane & 31;
    LAS char* wbase = (LAS char*)lds + wid * 8704;
    LAS char* kw = wbase + (lane >> 3) * 144 + (lane & 7) * 16;
    const LAS char* kr = wbase + qi * 144 + hi * 16;
    LAS char* vw = wbase + 4608 + ((lane & 7) >> 2) * 2048 + (lane >> 3) * 64 + (lane & 3) * 16;
    const LAS char* vr = wbase + 4608 + ((lane >> 4) & 1) * 32 + (lane & 3) * 8 + (4 * hi + ((lane & 15) >> 2)) * 64;
    for (int g = vcu; g < NB * NH * 8; g += G) {
        const int bh = g >> 3, c = ((g & 7) + 2 * (g / G)) & 7;
        const int b = bh >> 4, h = bh & 15;
        const size_t rowb = (size_t)b * SEQ;
        const int n16 = (c < 4 ? c : 4) + 1, n4 = c == 0 ? 4 : 8, n1 = c == 0 ? 16 : 20, ntot = 2 * n16 + n4 + n1;
        const int r16a = wid;
        bf16x8 qf[2][4];
#pragma unroll
        for (int q = 0; q < 2; ++q) { const bf16* qp = Q + (rowb + 512 * c + r16a + 8 * q + 16 * qi) * DM + h * HD + 8 * hi;
#pragma unroll
            for (int k = 0; k < 4; ++k) qf[q][k] = *(const bf16x8*)(qp + 16 * k); }
        AttnState st[2];
#pragma unroll
        for (int q = 0; q < 2; ++q) { st[q].o0 = f32x16{}; st[q].o1 = f32x16{}; st[q].m = 0.f; st[q].l = 0.f; }
#define DIL_LOAD(kx, vx, idx) do { int d_, r_, u0_, who_; dil_desc2((idx), c, r16a, n16, n4, d_, r_, u0_, who_); \
            attn_load_kv(kx, vx, K, V, rowb, (u0_ + (lane >> 3)) * d_ + r_, 8 * d_, h, lane); } while (0)
#define DIL_COMP(idx) do { int d_, r_, u0_, who_; dil_desc2((idx), c, r16a, n16, n4, d_, r_, u0_, who_); \
              \
            const int Wa_ = d_ == 16 ? 32 * c + qi : (d_ == 4 ? 128 * c + (r16a >> 2) + 4 * qi : 512 * c + r16a + 16 * qi); \
            const int Wb_ = d_ == 16 ? 32 * c + qi : (d_ == 4 ? 128 * c + (r16a >> 2) + 2 + 4 * qi : 512 * c + r16a + 8 + 16 * qi); \
            const int D0_[2] = {Wa_ - u0_ - 4 * hi, Wb_ - u0_ - 4 * hi}; \
            const bool first_[2] = {(idx) == 0, (idx) == n16}; const bool act_[2] = {who_ != 1, who_ != 0}; \
            const int kk_ = who_ == 0 ? (idx) : (idx) - n16; const bool in_ = who_ != 2 && kk_ >= 1 && kk_ <= 3;        \
            const bool aon_[2] = {in_, in_}; \
            attn_chunk2(st, qf, D0_, first_, act_, aon_, kr, vr); } while (0)
        ATT_LOOP(ntot, DIL_LOAD, DIL_COMP);
#undef DIL_LOAD
#undef DIL_COMP
#pragma unroll
        for (int q = 0; q < 2; ++q) attn_store(st[q], O + (rowb + 512 * c + r16a + 8 * q + 16 * qi) * DM + h * HD, hi);
    }
}

constexpr int MC_WAVE = 8704 + 2 * 4608, MC_ACC = 0, MC_ROW = 68, MC_CNT = 8 * MC_WAVE, MC_LIST = MC_CNT + 512, MC_END = MC_LIST + 768 * 4;
#define WG_BAR() asm volatile("s_waitcnt lgkmcnt(0)\n\ts_barrier" ::: "memory")
__device__ __forceinline__ unsigned moba_gate3(const bf16x8 (&qf)[4], const float* kmean, int b, int h, int hi, int own) {
    float g0 = -INFINITY, g1 = -INFINITY, g2 = -INFINITY; int i0 = -1, i1 = -1, i2 = -1;
    for (int n = 0; n < own; ++n) {
        const float* km = kmean + (size_t)(b * 16 + n) * DM + h * HD + 8 * hi;
        float acc = 0.f;
#pragma unroll
        for (int k = 0; k < 4; ++k) {
            const f32x4 ka = *(const f32x4*)(km + 16 * k), kb = *(const f32x4*)(km + 16 * k + 4);
#pragma unroll
            for (int e = 0; e < 4; ++e) {
                acc += __uint_as_float(((unsigned)(unsigned short)qf[k][e]) << 16) * ka[e];
                acc += __uint_as_float(((unsigned)(unsigned short)qf[k][4 + e]) << 16) * kb[e];
            }
        }
        const float gt = xhalf_sum(acc);
        if (gt > g0) { g2 = g1; i2 = i1; g1 = g0; i1 = i0; g0 = gt; i0 = n; }
        else if (gt > g1) { g2 = g1; i2 = i1; g1 = gt; i1 = n; }
        else if (gt > g2) { g2 = gt; i2 = n; }
    }
    return (unsigned)(i0 + 1) | ((unsigned)(i1 + 1) << 8) | ((unsigned)(i2 + 1) << 16);
}
__device__ __forceinline__ void moba_phase(LAS unsigned char* lds, const bf16* Q, const bf16* K, const bf16* V, const float* kmean, bf16* O, float* mp, float* ml, float* mm, int vcu, int G) {
    const int tid = threadIdx.x, lane = tid & 63, wid = __builtin_amdgcn_readfirstlane(tid >> 6), hi = lane >> 5, qi = lane & 31;
    LAS char* wbase = (LAS char*)lds + wid * MC_WAVE;
    LAS char* qr = wbase + 8704 + qi * 144 + hi * 16;
    LAS char* kw = wbase + (lane >> 3) * 144 + (lane & 7) * 16;
    const LAS char* kr = wbase + qi * 144 + hi * 16;
    LAS char* vw = wbase + 4608 + ((lane & 7) >> 2) * 2048 + (lane >> 3) * 64 + (lane & 3) * 16;
    const LAS char* vr = wbase + 4608 + ((lane >> 4) & 1) * 32 + (lane & 3) * 8 + (4 * hi + ((lane & 15) >> 2)) * 64;
    LAS float* acc = (LAS float*)(lds + MC_ACC);
    volatile LAS unsigned* cnt = (volatile LAS unsigned*)(lds + MC_CNT);
    volatile LAS unsigned* list = (volatile LAS unsigned*)(lds + MC_LIST);
    const int ql = 32 * wid + qi;
    const unsigned ltm = (1u << qi) - 1u;
    for (int u = vcu; u < NB * NH * 16; u += G) {
        int om = (G == 256) ? 2 * (u >> 8) + ((u >> 8) & 1) : 0; asm volatile("" : "+s"(om));
        const int bh = u >> 4, o = (u ^ om) & 15, b = bh >> 4, h = bh & 15;
        const size_t rowb = (size_t)b * SEQ;
        bf16x8 qf[2][4];
        { const bf16* qp = Q + (rowb + 256 * o + ql) * DM + h * HD + 8 * hi;
#pragma unroll
          for (int k = 0; k < 4; ++k) qf[0][k] = *(const bf16x8*)(qp + 16 * k); }
        const unsigned sbp = moba_gate3(qf[0], kmean, b, h, hi, o);
#define sb0 ((int)(sbp & 255u) - 1)
#define sb1 ((int)((sbp >> 8) & 255u) - 1)
#define sb2 ((int)((sbp >> 16) & 255u) - 1)
        AttnState st[2];
        WG_BAR();
        int pos0 = 0, pos1 = 0, pos2 = 0;
        for (int n = 0; n < o; ++n) {
            const unsigned b0 = (unsigned)__builtin_amdgcn_ballot_w64(sb0 == n), b1 = (unsigned)__builtin_amdgcn_ballot_w64(sb1 == n), b2 = (unsigned)__builtin_amdgcn_ballot_w64(sb2 == n);
            const int c0 = __builtin_popcount(b0), c1 = __builtin_popcount(b1), c2 = __builtin_popcount(b2);
            if (lane == 0) cnt[n * 8 + wid] = (unsigned)(c0 + c1 + c2);
            if (sb0 == n) pos0 = __builtin_popcount(b0 & ltm);
            if (sb1 == n) pos1 = c0 + __builtin_popcount(b1 & ltm);
            if (sb2 == n) pos2 = c0 + c1 + __builtin_popcount(b2 & ltm);
        }
        WG_BAR();
        { int pre = 0, base0 = 0, base1 = 0, base2 = 0;
          for (int n = 0; n < o; ++n) {
              int cb = 0, cl = 0;
#pragma unroll
              for (int w2 = 0; w2 < 8; ++w2) { const int cv = (int)cnt[n * 8 + w2]; cb += cv; if (w2 < wid) cl += cv; }
              if (sb0 == n) base0 = pre + cl;
              if (sb1 == n) base1 = pre + cl;
              if (sb2 == n) base2 = pre + cl;
              pre += cb;
          }
          if (hi == 0) {
              if (sb0 >= 0) list[base0 + pos0] = (unsigned)ql;
              if (sb1 >= 0) list[base1 + pos1] = (unsigned)ql | 256u;
              if (sb2 >= 0) list[base2 + pos2] = (unsigned)ql | 512u; } }
        WG_BAR();
        int pbase = 0, lbase = 0;
        for (int n = 0; n < o; ++n) {
            int c = 0;
#pragma unroll
            for (int w2 = 0; w2 < 8; ++w2) c += (int)cnt[n * 8 + w2];
            c = __builtin_amdgcn_readfirstlane(c);
            const int T = (c + 31) >> 5, NP = (T + 1) >> 1;
            for (int pi = 0; pi < NP; ++pi) {
                if (((pbase + pi) & 7) != wid) continue;
                const bool two = 2 * pi + 1 < T;
                { const int e0 = 64 * pi + qi, e1 = 64 * pi + 32 + qi;
                  const bool v0 = e0 < c, v1 = two && (e1 < c);
                  const int qs0 = (int)(list[lbase + (v0 ? e0 : 64 * pi)] & 255u), qs1 = (int)(list[lbase + (v1 ? e1 : (two ? 64 * pi + 32 : 64 * pi))] & 255u);
                  const bf16* qp0 = Q + (rowb + 256 * o + qs0) * DM + h * HD + 8 * hi; const bf16* qp1 = Q + (rowb + 256 * o + qs1) * DM + h * HD + 8 * hi;
                  bf16x8 t0[4], t1[4];
#pragma unroll
                  for (int kk = 0; kk < 4; ++kk) { t0[kk] = *(const bf16x8*)(qp0 + 16 * kk); t1[kk] = *(const bf16x8*)(qp1 + 16 * kk); }
#pragma unroll
                  for (int kk = 0; kk < 4; ++kk) { *(LAS bf16x8*)(qr + 32 * kk) = t0[kk]; *(LAS bf16x8*)(qr + 4608 + 32 * kk) = t1[kk]; } }
#pragma unroll
                for (int q = 0; q < 2; ++q) { st[q].o0 = f32x16{}; st[q].o1 = f32x16{}; st[q].m = 0.f; st[q].l = 0.f; }
#define MP_LOAD(kx, vx, idx) attn_load_kv(kx, vx, K, V, rowb, 256 * n + 32 * (idx) + (lane >> 3), 8, h, lane)
#define MP_COMP(idx) do { const int D0_[2] = {64, 64}; const bool first_[2] = {(idx) == 0, (idx) == 0}; const bool act_[2] = {true, two}; const bool aon_[2] = {true, true}; \
                    attn_chunk2<true>(st, qf, D0_, first_, act_, aon_, kr, vr, qr); } while (0)
                ATT_LOOP(8, MP_LOAD, MP_COMP);
#undef MP_LOAD
#undef MP_COMP
                const int e0 = 64 * pi + qi, e1 = 64 * pi + 32 + qi;
                const bool v0 = e0 < c, v1 = two && (e1 < c);
                const unsigned en0 = list[lbase + (v0 ? e0 : 64 * pi)], en1 = list[lbase + (v1 ? e1 : (two ? 64 * pi + 32 : 64 * pi))];
                const int qs0 = (int)(en0 & 255u), rk0 = (int)(en0 >> 8), qs1 = (int)(en1 & 255u), rk1 = (int)(en1 >> 8);
                const float lt0 = xhalf_sum(st[0].l), lt1 = xhalf_sum(st[1].l);
                const float f0 = 1.0f, f1 = 1.0f;
                if (v0) { float* d = mp + (size_t)(qs0 * 3 + rk0) * 64;
#pragma unroll
                    for (int g = 0; g < 4; ++g) {
                        *(f32x4*)(d + 8 * g + 4 * hi) = (f32x4){st[0].o0[4 * g], st[0].o0[4 * g + 1], st[0].o0[4 * g + 2], st[0].o0[4 * g + 3]} * f0;
                        *(f32x4*)(d + 32 + 8 * g + 4 * hi) = (f32x4){st[0].o1[4 * g], st[0].o1[4 * g + 1], st[0].o1[4 * g + 2], st[0].o1[4 * g + 3]} * f0; }
                    if (hi == 0) { ml[qs0 * 3 + rk0] = lt0 * f0; mm[qs0 * 3 + rk0] = st[0].m; } }
                if (v1) { float* d = mp + (size_t)(qs1 * 3 + rk1) * 64;
#pragma unroll
                    for (int g = 0; g < 4; ++g) {
                        *(f32x4*)(d + 8 * g + 4 * hi) = (f32x4){st[1].o0[4 * g], st[1].o0[4 * g + 1], st[1].o0[4 * g + 2], st[1].o0[4 * g + 3]} * f1;
                        *(f32x4*)(d + 32 + 8 * g + 4 * hi) = (f32x4){st[1].o1[4 * g], st[1].o1[4 * g + 1], st[1].o1[4 * g + 2], st[1].o1[4 * g + 3]} * f1; }
                    if (hi == 0) { ml[qs1 * 3 + rk1] = lt1 * f1; mm[qs1 * 3 + rk1] = st[1].m; } }
            }
            pbase += NP; lbase += c;
        }
        { const bf16* qp = Q + (rowb + 256 * o + ql) * DM + h * HD + 8 * hi;
#pragma unroll
          for (int k = 0; k < 4; ++k) qf[0][k] = *(const bf16x8*)(qp + 16 * k); }
#pragma unroll
        for (int q = 0; q < 2; ++q) { st[q].o0 = f32x16{}; st[q].o1 = f32x16{}; st[q].m = 0.f; st[q].l = 0.f; }
#pragma unroll
        for (int k = 0; k < 4; ++k) qf[1][k] = qf[0][k];
#define MC_LOAD(kx, vx, idx) attn_load_kv(kx, vx, K, V, rowb, 256 * o + 32 * (wid - (idx)) + (lane >> 3), 8, h, lane)
#define MC_COMP(idx) do { const int D0_[2] = {(idx) == 0 ? qi - 4 * hi : 64, 0}; const bool first_[2] = {(idx) == 0, false}; const bool act_[2] = {true, false}; const bool aon_[2] = {(idx) != 0, true}; \
            attn_chunk2(st, qf, D0_, first_, act_, aon_, kr, vr); } while (0)
        ATT_LOOP(wid + 1, MC_LOAD, MC_COMP);
#undef MC_LOAD
#undef MC_COMP
        asm volatile("s_waitcnt vmcnt(0)" ::: "memory");
        WG_BAR();
        __builtin_amdgcn_fence(__ATOMIC_ACQUIRE, "agent");
        { int qlu = ql; asm volatile("" : "+v"(qlu));
          float lsum = xhalf_sum(st[0].l); const float mq = st[0].m;
          f32x4 a0[4], a1[4];
#pragma unroll
          for (int g = 0; g < 4; ++g) { a0[g] = (f32x4){st[0].o0[4 * g], st[0].o0[4 * g + 1], st[0].o0[4 * g + 2], st[0].o0[4 * g + 3]}; a1[g] = (f32x4){st[0].o1[4 * g], st[0].o1[4 * g + 1], st[0].o1[4 * g + 2], st[0].o1[4 * g + 3]}; }
#pragma unroll
          for (int j = 0; j < 3; ++j) { const int sbj = j == 0 ? sb0 : (j == 1 ? sb1 : sb2);
              if (sbj >= 0) { const float* d = mp + (size_t)(qlu * 3 + j) * 64; const float fj = __builtin_amdgcn_exp2f(mm[qlu * 3 + j] - mq);
#pragma unroll
                  for (int g = 0; g < 4; ++g) { a0[g] += *(const f32x4*)(d + 8 * g + 4 * hi) * fj; a1[g] += *(const f32x4*)(d + 32 + 8 * g + 4 * hi) * fj; }
                  lsum += ml[qlu * 3 + j] * fj; } }
          const float inv = 1.0f / lsum;
          bf16* orow = O + (rowb + 256 * o + qlu) * DM + h * HD;
#pragma unroll
          for (int g = 0; g < 4; ++g) {
              const f32x4 v0 = a0[g] * inv, v1 = a1[g] * inv;
              u32x2 w0, w1; w0.x = cvtpk(v0[0], v0[1]); w0.y = cvtpk(v0[2], v0[3]); w1.x = cvtpk(v1[0], v1[1]); w1.y = cvtpk(v1[2], v1[3]);
              *(u32x2*)(orow + 8 * g + 4 * hi) = w0; *(u32x2*)(orow + 32 + 8 * g + 4 * hi) = w1; } }
    }
}
#define XB_TMO      128
#define XB_XCNT(j)  (256  + 64 * (j))
#define XB_XSUB(j)  (1280 + 64 * (j))
#define XB_XGEN(j)  (2304 + 64 * (j))
#define XB_TOP      3328
#define XB_TOPGEN   3392
#define XCD_BAR_WORDS 3456
#define XB_SPIN_CAP (1u << 18)

__device__ __forceinline__ unsigned xb_ld(unsigned* p)              { return __hip_atomic_load(p, __ATOMIC_RELAXED, __HIP_MEMORY_SCOPE_AGENT); }
__device__ __forceinline__ unsigned xb_add(unsigned* p, unsigned v) { return __hip_atomic_fetch_add(p, v, __ATOMIC_RELAXED, __HIP_MEMORY_SCOPE_AGENT); }
__device__ __forceinline__ unsigned xb_xcc_id() { return (unsigned)__builtin_amdgcn_s_getreg((3 << 11) | 20) & 0xFu; }
#define XB_SPIN(cond, bar) do { unsigned _sp = 0; while (cond) { __builtin_amdgcn_s_sleep(1); \
    if ((++_sp & 255u) == 0u) { if (xb_ld(&(bar)[XB_TMO])) break; if (_sp > XB_SPIN_CAP) { atomicAdd(&(bar)[XB_TMO], 1u); break; } } } } while (0)

struct XcdBarrier {
    unsigned* bar; unsigned x;
    volatile LAS unsigned* st;
};

__device__ __forceinline__ XcdBarrier xcd_barrier_post(unsigned* bar, volatile LAS unsigned* st) {
    XcdBarrier b; b.bar = bar; b.x = xb_xcc_id(); b.st = st;
    if (threadIdx.x == 0) (void)xb_add(&bar[XB_XCNT(b.x)], 1u);
    return b;
}
__device__ __forceinline__ void xcd_barrier_complete(unsigned* bar, unsigned x, unsigned& nloc, unsigned& nx) {
    const unsigned G = gridDim.x * gridDim.y * gridDim.z;
    unsigned sum, cnt, mine, sp = 0u;
    for (;;) {
        sum = 0u; cnt = 0u; mine = 0u;
#pragma unroll
        for (unsigned j = 0; j < 16; ++j) { const unsigned c = xb_ld(&bar[XB_XCNT(j)]); sum += c; cnt += (c > 0u) ? 1u : 0u; mine = (j == x) ? c : mine; }
        if (sum == G) break;
        __builtin_amdgcn_s_sleep(1);
        if ((++sp & 255u) == 0u) { if (xb_ld(&bar[XB_TMO])) break; if (sp > XB_SPIN_CAP) { atomicAdd(&bar[XB_TMO], 1u); break; } }
    }
    nloc = mine > 0u ? mine : 1u; nx = cnt > 0u ? cnt : 1u;
}

__device__ __forceinline__ void xcd_barrier(const XcdBarrier& b) {
    asm volatile("s_waitcnt vmcnt(0)" ::: "memory");
    __syncthreads();
    if (threadIdx.x == 0) {
        unsigned* bar = b.bar;
        __builtin_amdgcn_s_waitcnt(0);
        unsigned nloc = b.st[0], nx = b.st[1];
        if (nloc == 0u) { xcd_barrier_complete(bar, b.x, nloc, nx); b.st[0] = nloc; b.st[1] = nx; }
        const unsigned old = xb_add(&bar[XB_XSUB(b.x)], 1u);
        const unsigned gen = old / nloc;
        if (old + 1u == (gen + 1u) * nloc) {
            __builtin_amdgcn_fence(__ATOMIC_RELEASE, "agent");
            asm volatile("s_waitcnt vmcnt(0)" ::: "memory");
            const unsigned og = xb_add(&bar[XB_TOP], 1u);
            const unsigned tg = og / nx;
            if (og + 1u == (tg + 1u) * nx) xb_add(&bar[XB_TOPGEN], 1u);
            else XB_SPIN(xb_ld(&bar[XB_TOPGEN]) == tg, bar);
            __builtin_amdgcn_fence(__ATOMIC_ACQUIRE, "agent");
            xb_add(&bar[XB_XGEN(b.x)], 1u);
            asm volatile("s_waitcnt vmcnt(0)" ::: "memory");
        } else {
            XB_SPIN(xb_ld(&bar[XB_XGEN(b.x)]) == gen, bar);
            __builtin_amdgcn_fence(__ATOMIC_ACQUIRE, "agent");
            asm volatile("s_waitcnt vmcnt(0)" ::: "memory");
        }
    }
    __syncthreads();
}

__device__ __forceinline__ float wave_sum(float v) {
#pragma unroll
    for (int o = 1; o < 64; o <<= 1) v += __shfl_xor(v, o);
    return v;
}
__device__ __forceinline__ void transpose_item(const float* W, const float* gain, int K, int N, bf16* WT, int k0, int n0, int dst_row0, LAS float* scr, int lane) {
    f32x4 wv[8];
#pragma unroll
    for (int i = 0; i < 8; ++i) wv[i] = *(const f32x4*)(W + (size_t)(k0 + 8 * i + (lane >> 3)) * N + n0 + 4 * (lane & 7));
#pragma unroll
    for (int i = 0; i < 8; ++i) { const int kk = 8 * i + (lane >> 3); f32x4 w = wv[i]; if (gain) w = w * gain[k0 + kk];
#pragma unroll
        for (int e = 0; e < 4; ++e) scr[kk * 33 + 4 * (lane & 7) + e] = w[e]; }
    asm volatile("s_waitcnt lgkmcnt(0)" ::: "memory");
    const int c = lane & 7;
#pragma unroll
    for (int j = 0; j < 4; ++j) { const int n = (lane >> 3) + 8 * j; const LAS float* s = scr + (8 * c) * 33 + n;
        u32x4 o; o.x = pk2(s[0 * 33], s[1 * 33]); o.y = pk2(s[2 * 33], s[3 * 33]); o.z = pk2(s[4 * 33], s[5 * 33]); o.w = pk2(s[6 * 33], s[7 * 33]);
        *(u32x4*)(WT + (size_t)(dst_row0 + n) * K + k0 + 8 * c) = o; }
    asm volatile("s_waitcnt lgkmcnt(0)" ::: "memory");
}

#ifndef REP_P0
#define REP_P0 1
#endif
#ifndef REP_P1
#define REP_P1 1
#endif
#ifndef REP_P4
#define REP_P4 1
#endif
#ifndef REP_P11
#define REP_P11 1
#endif
#ifndef REP_P2
#define REP_P2 1
#endif
#ifndef REP_P3
#define REP_P3 1
#endif
struct Args { const float* in[17]; float* out; unsigned char* ws; int ph_lo, ph_hi; };
static_assert(sizeof(Args) == 17 * 8 + 8 + 8 + 8, "no padding bytes in Args");
enum { IN_X = 0, IN_F1N, IN_F1G, IN_F1U, IN_F1D, IN_MIXN, IN_F2N, IN_F2G, IN_F2U, IN_F2D, IN_AQKV, IN_AO, IN_KVN, IN_KVW, IN_BQ, IN_BO, IN_FINN };
constexpr int N_PHASES = 16;

__global__ void __launch_bounds__(NWAVES * 64, 2) fwd_kernel(Args args) {
    extern __shared__ __attribute__((aligned(16))) unsigned char lds_raw[];
    LAS unsigned char* lds = (LAS unsigned char*)lds_raw;
    const int tid = threadIdx.x, lane = tid & 63, wave = __builtin_amdgcn_readfirstlane(tid >> 6);
    const int G = gridDim.x, bx = blockIdx.x;
    const int vcu = (G % 8 == 0) ? (bx % 8) * (G / 8) + bx / 8 : bx;
    unsigned char* ws = args.ws;
    float* rope = (float*)(ws + WS_ROPE); float* kmp = (float*)(ws + WS_KMP); float* kmean = (float*)(ws + WS_KMEAN); float* ssq = (float*)(ws + WS_SSQ);
    bf16* wts = (bf16*)(ws + WS_W); bf16* hb = (bf16*)(ws + WS_HB); bf16* act = (bf16*)(ws + WS_ACT); bf16* qo = (bf16*)(ws + WS_ACT); bf16* ob = (bf16*)(ws + WS_ACT + 64 * MiB);
    bf16* kb = (bf16*)(ws + WS_K); bf16* vb = (bf16*)(ws + WS_V);
    float* out = args.out;
    const int lo = args.ph_lo, hi_ph = args.ph_hi;
    cg::grid_group grid = cg::this_grid();
#define IN(k) (lo <= (k) && (k) < hi_ph)
#define SEAM0(k) do { if (IN(k) && IN((k) + 1)) { asm volatile("s_waitcnt vmcnt(0)" ::: "memory"); __builtin_amdgcn_fence(__ATOMIC_RELEASE, "workgroup"); grid.sync(); } } while (0)
#define SEAM(k) do { if (IN(k) && IN((k) + 1)) xcd_barrier(bar); } while (0)
    static_assert(MC_END <= 147440, "MoBA LDS map below the barrier's set-up words");
    volatile LAS unsigned* bst = (volatile LAS unsigned*)(lds + 147440);
    if (tid < 2) bst[tid] = 0u;
    __syncthreads();
    unsigned* barw = (unsigned*)ws;
    XcdBarrier bar; bar.bar = barw; bar.x = 0u; bar.st = bst;

    if (IN(0)) {
        LAS float* scr = (LAS float*)(lds + wave * 16384);
        const int gw = vcu * NWAVES + wave, NGW = G * NWAVES;
        constexpr int I_F = 1408;
        constexpr int I_FFN = 12 * I_F, I_QKV = 16 * 96, I_SQ = 16 * 32, I_KV = 16 * 64, NITEMS = I_FFN + I_QKV + I_SQ + I_KV + I_SQ + I_SQ;
        for (int it = gw; it < NITEMS; it += NGW) {
            int r = it;
            if (r < I_FFN) {
                const int mi = r / I_F, item = r % I_F, L = mi / 6, which = (mi % 6) / 3, kind = mi % 3;
                bf16* base = wts + WO_FFN + (size_t)(L * 2 + which) * W_FFN;
                if (kind < 2) {
                    const float* W = (which ? (kind ? args.in[IN_F2U] : args.in[IN_F2G]) : (kind ? args.in[IN_F1U] : args.in[IN_F1G])) + (size_t)L * DM * FF;
                    const float* gn = (which ? args.in[IN_F2N] : args.in[IN_F1N]) + L * DM;
                    const int kbi = item / 88, nbi = item % 88, n0 = 32 * nbi;
                    transpose_item(W, gn, DM, FF, base, 64 * kbi, n0, 256 * (n0 >> 7) + (n0 & 127) + 128 * kind, scr, lane);
                } else {
                    const float* W = (which ? args.in[IN_F2D] : args.in[IN_F1D]) + (size_t)L * FF * DM;
                    const int kbi = item / 32, nbi = item % 32;
                    transpose_item(W, nullptr, FF, DM, base + W_GU, 64 * kbi, 32 * nbi, 32 * nbi, scr, lane);
                }
                continue;
            }
            r -= I_FFN;
            if (r < I_QKV) { transpose_item(args.in[IN_AQKV], args.in[IN_MIXN], DM, 3 * DM, wts + WO_QKV, 64 * (r / 96), 32 * (r % 96), 32 * (r % 96), scr, lane); continue; } r -= I_QKV;
            if (r < I_SQ) { transpose_item(args.in[IN_AO], nullptr, DM, DM, wts + WO_AO, 64 * (r / 32), 32 * (r % 32), 32 * (r % 32), scr, lane); continue; } r -= I_SQ;
            if (r < I_KV) { transpose_item(args.in[IN_KVW], args.in[IN_KVN], DM, 2 * DM, wts + WO_KV, 64 * (r / 64), 32 * (r % 64), 32 * (r % 64), scr, lane); continue; } r -= I_KV;
            if (r < I_SQ) { transpose_item(args.in[IN_BQ], args.in[IN_MIXN] + DM, DM, DM, wts + WO_BQ, 64 * (r / 32), 32 * (r % 32), 32 * (r % 32), scr, lane); continue; } r -= I_SQ;
            transpose_item(args.in[IN_BO], nullptr, DM, DM, wts + WO_BO, 64 * (r / 32), 32 * (r % 32), 32 * (r % 32), scr, lane);
        }
        const float* x = args.in[IN_X];
        for (int mb = gw; mb < MROWS; mb += 4 * NGW) {
            f32x4 v[4][4];
#pragma unroll
            for (int r = 0; r < 4; ++r) { const int m = mb + r * NGW; if (m < MROWS) { const f32x4* xr = (const f32x4*)(x + (size_t)m * DM) + lane;
#pragma unroll
                for (int j = 0; j < 4; ++j) v[r][j] = xr[64 * j]; } }
#pragma unroll
            for (int r = 0; r < 4; ++r) { const int m = mb + r * NGW; if (m < MROWS) {
                float s = 0.f;
#pragma unroll
                for (int j = 0; j < 4; ++j) s += (v[r][j][0] * v[r][j][0] + v[r][j][1] * v[r][j][1]) + (v[r][j][2] * v[r][j][2] + v[r][j][3] * v[r][j][3]);
                s = wave_sum(s);
                u32x2* o8 = (u32x2*)(hb + (size_t)m * DM) + lane;
#pragma unroll
                for (int j = 0; j < 4; ++j) { u32x2 w; w.x = cvtpk(v[r][j][0], v[r][j][1]); w.y = cvtpk(v[r][j][2], v[r][j][3]); o8[64 * j] = w; }
                if (lane < 16) ssq[(size_t)m * 16 + lane] = lane == 0 ? s : 0.f; } }
        }
        if (bx == 0) for (int i = tid; i < XCD_BAR_WORDS; i += NWAVES * 64) barw[i] = 0u;
        for (int idx = bx * (NWAVES * 64) + tid; idx < SEQ * 8; idx += G * NWAVES * 64) {
            const int pos = idx >> 3, i = idx & 7;
            const float inv_freq = i == 0 ? 1.0f : i == 1 ? 0.19392274474868576f : i == 2 ? 0.03760603093086393f : i == 3 ? 0.007292664737217109f : i == 4 ? 0.001414213562373095f
                                 : i == 5 ? 0.0002742481756762073f : i == 6 ? 5.318295896944988e-05f : 1.031338537721246e-05f;
            const float ang = (float)pos * inv_freq;
            const double qd = __builtin_rint((double)ang * 0.6366197723675814);
            const double y = __builtin_fma(-qd, 1.5707963267948966, (double)ang) - qd * 6.123233995736766e-17, y2 = y * y;
            const double sy = y * (1.0 + y2 * (-1.0 / 6 + y2 * (1.0 / 120 + y2 * (-1.0 / 5040 + y2 * (1.0 / 362880 + y2 * (-1.0 / 39916800 + y2 * (1.0 / 6227020800.0)))))));
            const double cy = 1.0 + y2 * (-0.5 + y2 * (1.0 / 24 + y2 * (-1.0 / 720 + y2 * (1.0 / 40320 + y2 * (-1.0 / 3628800 + y2 * (1.0 / 479001600 + y2 * (-1.0 / 87178291200.0)))))));
            const int qm = ((int)qd) & 3;
            const double cv = qm == 0 ? cy : qm == 1 ? -sy : qm == 2 ? -cy : sy, sv = qm == 0 ? sy : qm == 1 ? cy : qm == 2 ? -sy : -cy;
            rope[pos * 16 + i] = (float)cv; rope[pos * 16 + 8 + i] = (float)sv;
        }
    }
    SEAM0(0);
    if (IN(0) && IN(1)) bar = xcd_barrier_post(barw, bst);

#define GEMM_GU(L, which) do { pg8::Gemm g{hb, wts + WO_FFN + (size_t)((L) * 2 + (which)) * W_FFN, MROWS, 2 * FF, DM}; pg8::StaticOrder S; S.init(MROWS, 2 * FF, G, bx); \
        pg8::EpiSwiGLU E{act, ssq, FF}; pg8::gemm_phase<pg8::EpiSwiGLU, pg8::StaticOrder, true, true>(lds, g, S, E); } while (0)
#define GEMM_DOWN(L, which, basep, hbp) do { pg8::Gemm g{act, wts + WO_FFN + (size_t)((L) * 2 + (which)) * W_FFN + W_GU, MROWS, DM, FF}; pg8::StaticOrder S; S.init(MROWS, DM, G, bx); \
        pg8::EpiResid E{hb, ssq, 0.5f}; pg8::gemm_phase<pg8::EpiResid, pg8::StaticOrder, true, true>(lds, g, S, E); } while (0)
#define GEMM_WO(woff) do { pg8::Gemm g{ob, wts + (woff), MROWS, DM, DM}; pg8::StaticOrder S; S.init(MROWS, DM, G, bx); \
        pg8::EpiResid E{hb, ssq, 1.0f}; pg8::gemm_phase<pg8::EpiResid, pg8::StaticOrder, true, true>(lds, g, S, E); } while (0)

    if (IN(1)) for (int rep = 0; rep < REP_P1; ++rep) GEMM_GU(0, 0);
    SEAM(1);
    if (IN(2)) for (int rep = 0; rep < REP_P2; ++rep) GEMM_DOWN(0, 0, args.in[IN_X], hb);
    SEAM(2);
    if (IN(3)) for (int rep = 0; rep < REP_P3; ++rep) { pg8::Gemm g{hb, wts + WO_QKV, MROWS, 3 * DM, DM}; pg8::StaticOrder S; S.init(MROWS, 3 * DM, G, bx);
        pg8::EpiProj E{qo, (size_t)(WS_K - WS_ACT) / 2, (size_t)(WS_V - WS_K) / 2, 3u, 0u, ssq, rope, nullptr, C2}; pg8::gemm_phase<pg8::EpiProj, pg8::StaticOrder, true, true>(lds, g, S, E); }
    SEAM(3);
    if (IN(4)) for (int rep = 0; rep < REP_P4; ++rep) dilated_phase(lds, qo, kb, vb, ob, vcu, G);
    SEAM(4);
    if (IN(5)) GEMM_WO(WO_AO);
    SEAM(5);
    if (IN(6)) GEMM_GU(0, 1);
    SEAM(6);
    if (IN(7)) GEMM_DOWN(0, 1, out, hb);
    SEAM(7);
    if (IN(8)) {
        { pg8::Gemm g{hb, wts + WO_KV, MROWS, 2 * DM, DM}; pg8::StaticOrder S; S.init(MROWS, 2 * DM, G, bx);
          pg8::EpiProj E{kb, (size_t)(WS_V - WS_K) / 2, 0, 1u, 0u, ssq, rope, kmp, 1.0f}; pg8::gemm_phase<pg8::EpiProj, pg8::StaticOrder, true, true>(lds, g, S, E); }
        GEMM_GU(1, 0);
    }
    SEAM(8);
    if (IN(9)) GEMM_DOWN(1, 0, out, hb);
    SEAM(9);
    if (IN(10)) {
        for (int idx = bx * (NWAVES * 64) + tid; idx < 128 * DM; idx += G * NWAVES * 64) { const int blk = idx >> 10, col = idx & 1023;
            kmean[idx] = (kmp[(size_t)(blk * 2) * DM + col] + kmp[(size_t)(blk * 2 + 1) * DM + col]) * (1.0f / 256.0f); }
        pg8::Gemm g{hb, wts + WO_BQ, MROWS, DM, DM}; pg8::StaticOrder S; S.init(MROWS, DM, G, bx);
        pg8::EpiProj E{qo, 0, 0, 1u, 0u, ssq, rope, nullptr, C2}; pg8::gemm_phase<pg8::EpiProj, pg8::StaticOrder, true, true>(lds, g, S, E);
    }
    SEAM(10);
    if (IN(11)) for (int rep = 0; rep < REP_P11; ++rep) moba_phase(lds, qo, kb, vb, kmean, ob, (float*)(ws + WS_MP) + (size_t)bx * (256 * 3 * 64), (float*)(ws + WS_ML) + (size_t)bx * 768, (float*)(ws + WS_MM) + (size_t)bx * 768, vcu, G);
    SEAM(11);
    if (IN(12)) GEMM_WO(WO_BO);
    SEAM(12);
    if (IN(13)) GEMM_GU(1, 1);
    SEAM(13);
    if (IN(14)) GEMM_DOWN(1, 1, out, (bf16*)nullptr);
    SEAM(14);
    if (IN(15)) {
        const int gw = vcu * NWAVES + wave, NGW = G * NWAVES;
        const float* gfin = args.in[IN_FINN];
        f32x4 gv[4];
#pragma unroll
        for (int j = 0; j < 4; ++j) gv[j] = *(const f32x4*)(gfin + (j >> 1) * 512 + 8 * lane + 4 * (j & 1));
        for (int mb = gw; mb < MROWS; mb += 4 * NGW) {
            u32x4 v[4][2]; float rs[4];
#pragma unroll
            for (int r = 0; r < 4; ++r) { const int m = mb + r * NGW; if (m < MROWS) { rs[r] = pg8::row_rs(ssq, m);
                v[r][0] = *(const u32x4*)(hb + (size_t)m * DM + 8 * lane); v[r][1] = *(const u32x4*)(hb + (size_t)m * DM + 512 + 8 * lane); } }
#pragma unroll
            for (int r = 0; r < 4; ++r) { const int m = mb + r * NGW; if (m < MROWS) {
#pragma unroll
                for (int hf = 0; hf < 2; ++hf) { const u32x4 p = v[r][hf];
                    const f32x4 a0 = {__uint_as_float(p.x << 16), __uint_as_float(p.x & 0xffff0000u), __uint_as_float(p.y << 16), __uint_as_float(p.y & 0xffff0000u)};
                    const f32x4 a1 = {__uint_as_float(p.z << 16), __uint_as_float(p.z & 0xffff0000u), __uint_as_float(p.w << 16), __uint_as_float(p.w & 0xffff0000u)};
                    float* o = out + (size_t)m * DM + hf * 512 + 8 * lane;
                    *(f32x4*)o = a0 * rs[r] * gv[2 * hf]; *(f32x4*)(o + 4) = a1 * rs[r] * gv[2 * hf + 1]; } } }
        }
    }
#undef IN
#undef SEAM
#undef SEAM0
}

#ifndef MK_ONE_LAUNCH
#define MK_ONE_LAUNCH 1
#endif
extern "C" void kernel_launch(void* const* d_in, const int* in_sizes, int n_in, void* d_out, int out_size, void* d_ws, size_t ws_size, hipStream_t stream) {
    static int grid = 0;
    if (grid == 0) {
        if (n_in != 17 || in_sizes[0] != MROWS * DM || out_size != MROWS * DM || ws_size < WS_END) {
            fprintf(stderr, "kernel_launch: unexpected shapes (n_in %d, in0 %d, out %d, ws %zu)\n", n_in, n_in > 0 ? in_sizes[0] : -1, out_size, ws_size); grid = -1; return; }
        int dev = 0, cus = 0, per_cu = 0;
        (void)hipGetDevice(&dev); (void)hipDeviceGetAttribute(&cus, hipDeviceAttributeMultiprocessorCount, dev);
        if (hipFuncSetAttribute((const void*)fwd_kernel, hipFuncAttributeMaxDynamicSharedMemorySize, LDS_BYTES) != hipSuccess) { fprintf(stderr, "kernel_launch: hipFuncSetAttribute failed\n"); grid = -1; return; }
        if (hipOccupancyMaxActiveBlocksPerMultiprocessor(&per_cu, (const void*)fwd_kernel, NWAVES * 64, LDS_BYTES) != hipSuccess || per_cu < 1) { fprintf(stderr, "kernel_launch: occupancy query gives %d\n", per_cu); per_cu = 1; }
        (void)hipGetLastError();
        grid = cus * per_cu;
        if (grid % 8 != 0 || grid <= 0) { fprintf(stderr, "kernel_launch: grid %d not a multiple of 8\n", grid); }
    }
    if (grid < 0) return;
    Args a{};
    for (int i = 0; i < 17; ++i) a.in[i] = (const float*)d_in[i];
    a.out = (float*)d_out; a.ws = (unsigned char*)d_ws;
#if MK_ONE_LAUNCH
    a.ph_lo = 0; a.ph_hi = N_PHASES;
    void* kargs[] = {&a};
    hipError_t e = hipLaunchCooperativeKernel((const void*)fwd_kernel, dim3(grid), dim3(NWAVES * 64), kargs, LDS_BYTES, stream);
    if (e != hipSuccess) fprintf(stderr, "kernel_launch: cooperative launch failed: %s (grid %d)\n", hipGetErrorString(e), grid);
#else
    for (int ph = 0; ph < N_PHASES; ++ph) {
        a.ph_lo = ph; a.ph_hi = ph + 1;
        hipLaunchKernelGGL(fwd_kernel, dim3(grid), dim3(NWAVES * 64), LDS_BYTES, stream, a);
    }
#endif
}
#undef sb0
#undef sb1
#undef sb2
```
